# Optimizing an MI355X kernel written in HIP

```python
import math
import jax, jax.numpy as jnp
from jax import lax
import numpy as np

D_MODEL = 1024
BATCH = 2
SEQ = 8192
DEPTH = 1
DEC_BATCH = 128
DEC_SEQ = 4
PAST_LEN = 8192
PAGE_SIZE = 128

HEAD_DIM = 64
N_HEADS = D_MODEL // HEAD_DIM
A_Q_HEADS = N_HEADS // 2
A_KV_HEADS = A_Q_HEADS // 4
A_GROUP = A_Q_HEADS // A_KV_HEADS
B_HEADS = N_HEADS - A_Q_HEADS
A_WINDOW = 128
BLOCK = 128
B_PATTERNS = ((128, 1), (512, 4), (2048, 16))
B_WINDOW = max(w for w, _ in B_PATTERNS)
D_FF = -(-8 * D_MODEL // (3 * 256)) * 256
ROPE_THETA = 10000.0
EPS = 1e-6
A_QW = A_Q_HEADS * HEAD_DIM
A_KVW = A_KV_HEADS * HEAD_DIM
B_W = B_HEADS * HEAD_DIM
IN_COLS = A_QW + 2 * A_KVW + 3 * B_W
SPLIT_IDX = (A_QW, A_QW + A_KVW, A_QW + 2 * A_KVW, A_QW + 2 * A_KVW + B_W, A_QW + 2 * A_KVW + 2 * B_W)
SCALE = HEAD_DIM ** -0.5

kernel_name = 'hymba_swa_sink_dilated_decode_step'


def rms_norm(x, g):
    xf = x.astype(jnp.float32)
    y = xf * lax.rsqrt(jnp.mean(xf * xf, axis=-1, keepdims=True) + EPS)
    return (y * g.astype(jnp.float32)).astype(x.dtype)


def rotary(x, pos):
    half = HEAD_DIM // 2
    inv = jnp.exp(-math.log(ROPE_THETA) * jnp.arange(half, dtype=jnp.float32) * (2.0 / HEAD_DIM))
    ang = pos.astype(jnp.float32)[:, None] * inv[None, :]
    cos = jnp.cos(ang)[:, None, :]
    sin = jnp.sin(ang)[:, None, :]
    xf = x.astype(jnp.float32)
    x1, x2 = xf[..., :half], xf[..., half:]
    return jnp.concatenate([x1 * cos - x2 * sin, x2 * cos + x1 * sin], axis=-1).astype(x.dtype)


def _adaln(c, w, b):
    mod = jax.nn.silu(c) @ w + b
    return jnp.split(mod[:, None, :], 6, axis=-1)


def _modulate(h, shift, scale):
    return h * (1 + scale) + shift


def _band_blocks(t, n_blocks, extra_end):
    pad = [(0, 0), (BLOCK, extra_end)] + [(0, 0)] * (t.ndim - 2)
    tb = jnp.pad(t, pad).reshape((t.shape[0], n_blocks + 1, BLOCK) + t.shape[2:])
    return jnp.concatenate([tb[:, :-1], tb[:, 1:]], axis=2)


def _band_mask(n_blocks, max_dist):
    qi = jnp.arange(BLOCK)[:, None]
    ki = jnp.arange(2 * BLOCK)[None, :]
    rel = qi + BLOCK - ki
    kpos = jnp.arange(n_blocks)[:, None, None] * BLOCK - BLOCK + ki
    return (rel >= 0) & (rel <= max_dist) & (kpos >= 0)


def _sink_probs(s, mask, sink):
    s = jnp.where(mask, s, -jnp.inf)
    m = jnp.maximum(jnp.max(s, axis=-1, keepdims=True), sink)
    p = jnp.exp(s - m)
    return p / (jnp.sum(p, axis=-1, keepdims=True) + jnp.exp(sink - m))


def _lse_probs(s, mask):
    s = jnp.where(mask, s, -jnp.inf)
    m = jnp.max(s, axis=-1, keepdims=True)
    p = jnp.exp(s - m)
    l = jnp.sum(p, axis=-1, keepdims=True)
    return p / l, (m + jnp.log(l))[..., 0]


def swa_sink_prompt(q, k, v, sinks):
    n, S = q.shape[0], q.shape[1]
    nb = S // BLOCK
    qb = q.astype(jnp.float32).reshape(n, nb, BLOCK, A_KV_HEADS, A_GROUP, HEAD_DIM)
    kb = _band_blocks(k.astype(jnp.float32), nb, 0)
    vb = _band_blocks(v.astype(jnp.float32), nb, 0)
    s = jnp.einsum('bnqhge,bnkhe->bnhgqk', qb, kb) * SCALE
    mask = _band_mask(nb, A_WINDOW - 1)[None, :, None, None]
    sink = sinks.astype(jnp.float32).reshape(A_KV_HEADS, A_GROUP)[None, None, :, :, None, None]
    p = _sink_probs(s, mask, sink)
    o = jnp.einsum('bnhgqk,bnkhe->bnqhge', p, vb)
    return o.reshape(n, S, A_QW).astype(q.dtype)


def swa_sink_sample(q, k_new, v_new, k_cache, v_cache, sinks):
    n, T = q.shape[0], q.shape[1]
    WA = k_cache.shape[1]
    k_all = jnp.concatenate([k_cache.astype(k_new.dtype), k_new], axis=1)
    v_all = jnp.concatenate([v_cache.astype(v_new.dtype), v_new], axis=1)
    qg = q.astype(jnp.float32).reshape(n, T, A_KV_HEADS, A_GROUP, HEAD_DIM)
    s = jnp.einsum('bqhge,bkhe->bhgqk', qg, k_all.astype(jnp.float32)) * SCALE
    rel = (WA + jnp.arange(T))[:, None] - jnp.arange(WA + T)[None, :]
    mask = ((rel >= 0) & (rel < A_WINDOW))[None, None, None]
    sink = sinks.astype(jnp.float32).reshape(A_KV_HEADS, A_GROUP)[None, :, :, None, None]
    p = _sink_probs(s, mask, sink)
    o = jnp.einsum('bhgqk,bkhe->bqhge', p, v_all.astype(jnp.float32))
    return o.reshape(n, T, A_QW).astype(q.dtype), k_all[:, -WA:], v_all[:, -WA:]


def _dilated_branch_prompt(q, k, v, window, dil):
    n, S, H, Dh = q.shape
    J = window // dil
    M = S // dil
    Mp = -(-M // BLOCK) * BLOCK
    nb = Mp // BLOCK
    split = lambda t: t.reshape(n, M, dil, H, Dh)
    qb = jnp.pad(split(q), ((0, 0), (0, Mp - M), (0, 0), (0, 0), (0, 0))).reshape(n, nb, BLOCK, dil, H, Dh)
    kb = _band_blocks(split(k), nb, Mp - M)
    vb = _band_blocks(split(v), nb, Mp - M)
    s = jnp.einsum('bnqrhe,bnkrhe->bnrhqk', qb, kb) * SCALE
    p, lse = _lse_probs(s, _band_mask(nb, J)[None, :, None, None])
    o = jnp.einsum('bnrhqk,bnkrhe->bnqrhe', p, vb).reshape(n, Mp, dil, H, Dh)[:, :M].reshape(n, S, H, Dh)
    lse = jnp.transpose(lse, (0, 1, 4, 2, 3)).reshape(n, Mp, dil, H)[:, :M].reshape(n, S, H)
    return o, lse


def _mix_dilations(outs, lses):
    alpha = jax.nn.softmax(jnp.stack(lses), axis=0)
    o = jnp.sum(alpha[..., None] * jnp.stack(outs), axis=0)
    return o.reshape(o.shape[0], o.shape[1], B_W)


def dilated_prompt(q, k, v):
    qf, kf, vf = q.astype(jnp.float32), k.astype(jnp.float32), v.astype(jnp.float32)
    outs, lses = [], []
    for window, dil in B_PATTERNS:
        o, lse = _dilated_branch_prompt(qf, kf, vf, window, dil)
        outs.append(o)
        lses.append(lse)
    return _mix_dilations(outs, lses).astype(q.dtype)


def dilated_sample(q, k_new, v_new, k_cache, v_cache):
    T = q.shape[1]
    WB = k_cache.shape[1]
    k_all = jnp.concatenate([k_cache.astype(k_new.dtype), k_new], axis=1)
    v_all = jnp.concatenate([v_cache.astype(v_new.dtype), v_new], axis=1)
    qf, kf, vf = q.astype(jnp.float32), k_all.astype(jnp.float32), v_all.astype(jnp.float32)
    outs, lses = [], []
    for window, dil in B_PATTERNS:
        J = window // dil
        idx = (WB + jnp.arange(T))[:, None] - dil * jnp.arange(J + 1)[None, :]
        valid = idx >= 0
        idx = jnp.maximum(idx, 0)
        kg, vg = kf[:, idx], vf[:, idx]
        s = jnp.einsum('bqhe,bqjhe->bhqj', qf, kg) * SCALE
        p, lse = _lse_probs(s, valid[None, None])
        outs.append(jnp.einsum('bhqj,bqjhe->bqhe', p, vg))
        lses.append(jnp.transpose(lse, (0, 2, 1)))
    return _mix_dilations(outs, lses).astype(q.dtype), k_all[:, -WB:], v_all[:, -WB:]


def _attn_inputs(x, shift, scale, g, w_in, pos):
    h = _modulate(rms_norm(x, g), shift, scale)
    proj = h @ w_in
    n, L = x.shape[0], x.shape[1]
    qa, ka, va, qb, kb, vb = jnp.split(proj, SPLIT_IDX, axis=-1)
    heads = lambda t, nh: t.reshape(n, L, nh, HEAD_DIM)
    return (rotary(heads(qa, A_Q_HEADS), pos), rotary(heads(ka, A_KV_HEADS), pos), heads(va, A_KV_HEADS),
            rotary(heads(qb, B_HEADS), pos), rotary(heads(kb, B_HEADS), pos), heads(vb, B_HEADS))


def _merge(oa, ob, g_oa, g_ob, w_o):
    return jnp.concatenate([rms_norm(oa, g_oa), rms_norm(ob, g_ob)], axis=-1) @ w_o


def _ffn_sub(x, shift, scale, gate, g, w_gate, w_up, w_down):
    h = _modulate(rms_norm(x, g), shift, scale)
    return x + gate * ((jax.nn.silu(h @ w_gate) * (h @ w_up)) @ w_down)


def setup_inputs(seed: int = 0) -> dict:
    key = jax.random.key(seed)
    ks = jax.random.split(key, 24)
    f32 = jnp.float32
    nrm = lambda k, shape, s: jax.random.normal(k, shape, f32) * s
    WA = min(A_WINDOW, PAST_LEN)
    WB = min(B_WINDOW, PAST_LEN)
    D = D_MODEL
    return {
        'x_prompt': nrm(ks[0], (BATCH, SEQ, D), 1.0),
        'x_sample': nrm(ks[1], (DEC_BATCH, DEC_SEQ, D), 1.0),
        'c_prompt': nrm(ks[2], (BATCH, D), 1.0),
        'c_sample': nrm(ks[3], (DEC_BATCH, D), 1.0),
        'cache_a_k': nrm(ks[4], (DEPTH, DEC_BATCH, WA, A_KV_HEADS, HEAD_DIM), 1.0),
        'cache_a_v': nrm(ks[5], (DEPTH, DEC_BATCH, WA, A_KV_HEADS, HEAD_DIM), 1.0),
        'cache_b_k': nrm(ks[6], (DEPTH, DEC_BATCH, WB, B_HEADS, HEAD_DIM), 1.0),
        'cache_b_v': nrm(ks[7], (DEPTH, DEC_BATCH, WB, B_HEADS, HEAD_DIM), 1.0),
        'w_ada': nrm(ks[8], (DEPTH, D, 6 * D), 0.5 * D ** -0.5),
        'b_ada': nrm(ks[9], (DEPTH, 6 * D), 0.01),
        'g_attn': 1.0 + nrm(ks[10], (DEPTH, D), 0.01),
        'w_in': nrm(ks[11], (DEPTH, D, IN_COLS), D ** -0.5),
        'sinks': nrm(ks[12], (DEPTH, A_Q_HEADS), 1.0),
        'g_out_a': 1.0 + nrm(ks[13], (DEPTH, A_QW), 0.01),
        'g_out_b': 1.0 + nrm(ks[14], (DEPTH, B_W), 0.01),
        'w_o': nrm(ks[15], (DEPTH, A_QW + B_W, D), (A_QW + B_W) ** -0.5),
        'g_ffn': 1.0 + nrm(ks[16], (DEPTH, D), 0.01),
        'w_gate': nrm(ks[17], (DEPTH, D, D_FF), D ** -0.5),
        'w_up': nrm(ks[18], (DEPTH, D, D_FF), D ** -0.5),
        'w_down': nrm(ks[19], (DEPTH, D_FF, D), D_FF ** -0.5),
        'g_final': 1.0 + nrm(ks[20], (D,), 0.01),
    }


def reference(x_prompt, x_sample, c_prompt, c_sample, cache_a_k, cache_a_v, cache_b_k, cache_b_v,
              w_ada, b_ada, g_attn, w_in, sinks, g_out_a, g_out_b, w_o, g_ffn, w_gate, w_up, w_down, g_final):
    S = x_prompt.shape[1]
    pos_p = jnp.arange(S, dtype=jnp.int32)
    pos_s = PAST_LEN + jnp.arange(x_sample.shape[1], dtype=jnp.int32)
    xp, xs = x_prompt, x_sample
    pa_k, pa_v, pb_k, pb_v, sa_k, sa_v, sb_k, sb_v = ([] for _ in range(8))
    for l in range(DEPTH):
        sh_a_p, sc_a_p, gt_a_p, sh_f_p, sc_f_p, gt_f_p = _adaln(c_prompt, w_ada[l], b_ada[l])
        sh_a_s, sc_a_s, gt_a_s, sh_f_s, sc_f_s, gt_f_s = _adaln(c_sample, w_ada[l], b_ada[l])
        qa, ka, va, qb, kb, vb = _attn_inputs(xp, sh_a_p, sc_a_p, g_attn[l], w_in[l], pos_p)
        oa = swa_sink_prompt(qa, ka, va, sinks[l])
        ob = dilated_prompt(qb, kb, vb)
        xp = xp + gt_a_p * _merge(oa, ob, g_out_a[l], g_out_b[l], w_o[l])
        xp = _ffn_sub(xp, sh_f_p, sc_f_p, gt_f_p, g_ffn[l], w_gate[l], w_up[l], w_down[l])
        pa_k.append(ka[:, -min(A_WINDOW, S):])
        pa_v.append(va[:, -min(A_WINDOW, S):])
        pb_k.append(kb[:, -min(B_WINDOW, S):])
        pb_v.append(vb[:, -min(B_WINDOW, S):])
        qa, ka, va, qb, kb, vb = _attn_inputs(xs, sh_a_s, sc_a_s, g_attn[l], w_in[l], pos_s)
        oa, na_k, na_v = swa_sink_sample(qa, ka, va, cache_a_k[l], cache_a_v[l], sinks[l])
        ob, nb_k, nb_v = dilated_sample(qb, kb, vb, cache_b_k[l], cache_b_v[l])
        xs = xs + gt_a_s * _merge(oa, ob, g_out_a[l], g_out_b[l], w_o[l])
        xs = _ffn_sub(xs, sh_f_s, sc_f_s, gt_f_s, g_ffn[l], w_gate[l], w_up[l], w_down[l])
        sa_k.append(na_k)
        sa_v.append(na_v)
        sb_k.append(nb_k)
        sb_v.append(nb_v)
    y_prompt = rms_norm(xp, g_final)
    y_sample = rms_norm(xs, g_final)
    return (y_prompt, y_sample, jnp.stack(pa_k), jnp.stack(pa_v), jnp.stack(pb_k), jnp.stack(pb_v),
            jnp.stack(sa_k), jnp.stack(sa_v), jnp.stack(sb_k), jnp.stack(sb_v))
```

```cpp
#include <hip/hip_runtime.h>
#include <cstdio>
#include <cstdint>

constexpr int D = 1024, SEQ = 8192, NB = 2, DB = 128, DS = 4;
constexpr int MP = NB * SEQ, MS = DB * DS, MT = MP + MS;
constexpr int INC = 2304, FF = 2816, NMOD = 6144, NMB = NB + DB;
constexpr int WA = 128, WB = 2048, NPOS = SEQ + DS;
constexpr float EPS = 1e-6f;
constexpr float C2 = 0.125f * 1.4426950408889634f;
constexpr float LOG2E = 1.4426950408889634f;
constexpr size_t O_Y = 0;
constexpr size_t O_PAK = (size_t)MT * D;
constexpr size_t O_PAV = O_PAK + (size_t)NB * WA * 128;
constexpr size_t O_PBK = O_PAV + (size_t)NB * WA * 128;
constexpr size_t O_PBV = O_PBK + (size_t)NB * WB * 512;
constexpr size_t O_SAK = O_PBV + (size_t)NB * WB * 512;
constexpr size_t O_SAV = O_SAK + (size_t)DB * WA * 128;
constexpr size_t O_SBK = O_SAV + (size_t)DB * WA * 128;
constexpr size_t O_SBV = O_SBK + (size_t)DB * WB * 512;
constexpr size_t O_END = O_SBV + (size_t)DB * WB * 512;
static_assert(O_END == 294191104ull, "output map");

__device__ __forceinline__ int mod_row(int r) { return r < MP ? (r >> 13) : NB + ((r - MP) >> 2); }
__device__ __forceinline__ int pos_of(int r) { return r < MP ? (r & (SEQ - 1)) : SEQ + ((r - MP) & 3); }

namespace pg8 {
#define PG8_LAS __attribute__((address_space(3)))
typedef unsigned short bf16_t;
typedef short bf16x8 __attribute__((ext_vector_type(8)));
typedef float f32x4 __attribute__((ext_vector_type(4)));
typedef unsigned u32x4 __attribute__((ext_vector_type(4)));
constexpr int BM = 256, BK = 64, HALF = 128, HTB = HALF * BK * 2  , STAGE_BYTES = 8 * HTB, NXCD = 8, WGM = 8;

__host__ __device__ __forceinline__ int lds_byte(int r, int c) { const int st = (r >> 4) * 2 + (c >> 5), rr = r & 15, cc = c & 31, ob = rr * 64 + cc * 2; return st * 1024 + (ob ^ (((ob >> 9) & 1) << 5)); }
__host__ __device__ __forceinline__ void stage_rc(int b, int& R, int& C) { const int st = b / 1024, sb = b % 1024, swz = sb ^ (((sb >> 9) & 1) << 5); R = (st >> 1) * 16 + swz / 64; C = (st & 1) * 32 + (swz % 64) / 2; }
__host__ __device__ __forceinline__ int perm32(int rho) { const int n = rho >> 4, i = rho & 15; return 8 * (i >> 2) + 4 * n + (i & 3); }

struct Unit { int pm, pn; };
struct Gemm { const bf16_t* A; const bf16_t* Bt; int M, N, K; };

struct StaticOrder {
    int nM, nN, nwg, G, c;
    __host__ __device__ void init(int M, int N, int G_, int c_) { nM = M / BM; nN = N / BM; nwg = nM * nN; G = G_; c = c_; }
    __host__ __device__ bool next(int i, Unit& u) const {
        const long L = (long)i * G + c; if (L >= nwg) return false;
        int wgid = (int)L; { const int q = nwg / NXCD, r = nwg % NXCD, xcd = wgid % NXCD, off = wgid / NXCD; wgid = (xcd < r ? xcd * (q + 1) : r * (q + 1) + (xcd - r) * q) + off; }
        const int nig = WGM * nN, gid = wgid / nig, fm = gid * WGM, gsz = (nM - fm) < WGM ? (nM - fm) : WGM;
        u.pm = fm + ((wgid % nig) % gsz); u.pn = (wgid % nig) / gsz; return true;
    }
    __device__ __forceinline__ void a_ready(const Unit&) const {}
    __device__ __forceinline__ void done(const Unit&) const {}
};


typedef float f32x2v __attribute__((ext_vector_type(2)));
typedef unsigned u32x2v __attribute__((ext_vector_type(2)));
__device__ __forceinline__ unsigned cvt_pk_bf16(float lo, float hi) { unsigned r; asm volatile("v_cvt_pk_bf16_f32 %0, %1, %2" : "=v"(r) : "v"(lo), "v"(hi)); return r; }

struct EpiQKV {
    static constexpr bool PERM = true, AFTER_DRAIN = false; static constexpr int MID_T = 0;
    bf16_t* QKV; const float* COS; const float* SIN; float* out;
    __device__ __forceinline__ void operator()(const f32x4 (&acc)[2][2][4][2], const Unit& u, int ui, int wr, int wc, int fr, int fq) const {
        (void)ui;
        const int rowt = u.pm * BM + wr * 64 + fr;
        const bool samp = u.pm >= MP / BM;
        const int i0 = 16 * (wc & 1) + 4 * fq;
#pragma unroll
        for (int bj = 0; bj < 2; ++bj) {
            const int pc = u.pn * BM + bj * HALF + wc * 32 + 8 * fq;
            const int h64 = u.pn * 4 + bj * 2 + (wc >> 1);
            const bool isq = h64 < 8 || (h64 >= 12 && h64 < 20);
            const bool isk = (h64 >= 8 && h64 < 10) || (h64 >= 20 && h64 < 28);
            const bool isA = h64 >= 8 && h64 < 12, isB = h64 >= 20;
            const bool isv = !isq && !isk;
            const int hk = isA ? (h64 & 1) : ((h64 - 20) & 7);
            float* cbase = out;
            if (isA) cbase = out + (samp ? (isk ? O_SAK : O_SAV) : (isk ? O_PAK : O_PAV));
            if (isB) cbase = out + (samp ? (isk ? O_SBK : O_SBV) : (isk ? O_PBK : O_PBV));
            const int off1 = isk ? i0 : (pc & 63), off2 = isk ? 32 + i0 : (pc & 63) + 4;
#pragma unroll
            for (int ai = 0; ai < 2; ++ai)
#pragma unroll
                for (int m = 0; m < 4; ++m) {
                    const int row = rowt + ai * HALF + m * 16;
                    f32x4 v0 = acc[ai][bj][m][0], v1 = acc[ai][bj][m][1];
                    if (!isv) {
                        const int pos = samp ? SEQ + (row & 3) : (row & (SEQ - 1));
                        const f32x4 cs = *(const f32x4*)(COS + pos * 32 + i0), sn = *(const f32x4*)(SIN + pos * 32 + i0);
                        const f32x4 a = v0 * cs - v1 * sn, b = v1 * cs + v0 * sn;
                        v0 = a; v1 = b;
                        if (isq) { v0 = v0 * C2; v1 = v1 * C2; }
                    }
                    u32x4 w; w.x = cvt_pk_bf16(v0[0], v0[1]); w.y = cvt_pk_bf16(v0[2], v0[3]); w.z = cvt_pk_bf16(v1[0], v1[1]); w.w = cvt_pk_bf16(v1[2], v1[3]);
                    *(u32x4*)(QKV + (size_t)row * INC + pc) = w;
                    if (isA || isB) {
                        long slot = -1;
                        if (samp) { const int bs = (row - MP) >> 2, ii = row & 3; slot = isA ? (long)(bs * WA + WA - DS + ii) * 2 : (long)(bs * WB + WB - DS + ii) * 8; }
                        else { const int b = u.pm >> 5, t = row & (SEQ - 1);
                            if (isA) { if (t >= SEQ - WA) slot = (long)(b * WA + t - (SEQ - WA)) * 2; }
                            else { if (t >= SEQ - WB) slot = (long)(b * WB + t - (SEQ - WB)) * 8; } }
                        if (slot >= 0) { float* dst = cbase + (slot + hk) * 64; *(f32x4*)(dst + off1) = v0; *(f32x4*)(dst + off2) = v1; }
                    }
                }
        }
    }
};

struct EpiOut {
    static constexpr bool PERM = false, AFTER_DRAIN = false; static constexpr int MID_T = 8;
    const float* xp; const float* xs; const float* mod; float* X1; const PG8_LAS f32x2v* tab;
    __device__ __forceinline__ void mid(f32x4 (&acc)[2][2][4][2], int ui, int wr, int fr) const {
#pragma unroll
        for (int ai = 0; ai < 2; ++ai)
#pragma unroll
            for (int m = 0; m < 4; ++m) { const float ratio = tab[(ui & 1) * 256 + ai * HALF + wr * 64 + m * 16 + fr].x;
#pragma unroll
                for (int bj = 0; bj < 2; ++bj)
#pragma unroll
                    for (int n = 0; n < 2; ++n) acc[ai][bj][m][n] = acc[ai][bj][m][n] * ratio; }
    }
    __device__ __forceinline__ void operator()(const f32x4 (&acc)[2][2][4][2], const Unit& u, int ui, int wr, int wc, int fr, int fq) const {
        const int col0 = u.pn * BM + wc * 32 + 4 * fq;
#pragma unroll
        for (int ai = 0; ai < 2; ++ai)
#pragma unroll
            for (int m = 0; m < 4; ++m) { const int rl = ai * HALF + wr * 64 + m * 16 + fr, row = u.pm * BM + rl; const float rb = tab[(ui & 1) * 256 + rl].y;
                const float* xrow = row < MP ? xp + (size_t)row * D : xs + (size_t)(row - MP) * D;
                const float* grow = mod + (size_t)mod_row(row) * NMOD + 2048;
#pragma unroll
                for (int bj = 0; bj < 2; ++bj)
#pragma unroll
                    for (int n = 0; n < 2; ++n) { const int col = col0 + bj * HALF + n * 16; const f32x4 x4 = *(const f32x4*)(xrow + col), g4 = *(const f32x4*)(grow + col);
                        *(f32x4*)(X1 + (size_t)row * D + col) = x4 + g4 * (acc[ai][bj][m][n] * rb); } }
    }
};

struct EpiGU {
    static constexpr bool PERM = true, AFTER_DRAIN = false; static constexpr int MID_T = 0;
    bf16_t* HM;
    __device__ __forceinline__ float silu_mul(float g, float u) const { return g * u * __builtin_amdgcn_rcpf(1.0f + __builtin_amdgcn_exp2f(-LOG2E * g)); }
    __device__ __forceinline__ void operator()(const f32x4 (&acc)[2][2][4][2], const Unit& u, int ui, int wr, int wc, int fr, int fq) const {
        (void)ui;
        const int row0 = u.pm * BM + wr * 64 + fr, col = u.pn * HALF + wc * 32 + 8 * fq;
#pragma unroll
        for (int ai = 0; ai < 2; ++ai)
#pragma unroll
            for (int m = 0; m < 4; ++m) { const f32x4 g0 = acc[ai][0][m][0], g1 = acc[ai][0][m][1], u0 = acc[ai][1][m][0], u1 = acc[ai][1][m][1];
                u32x4 w; w.x = cvt_pk_bf16(silu_mul(g0[0], u0[0]), silu_mul(g0[1], u0[1])); w.y = cvt_pk_bf16(silu_mul(g0[2], u0[2]), silu_mul(g0[3], u0[3]));
                w.z = cvt_pk_bf16(silu_mul(g1[0], u1[0]), silu_mul(g1[1], u1[1])); w.w = cvt_pk_bf16(silu_mul(g1[2], u1[2]), silu_mul(g1[3], u1[3]));
                *(u32x4*)(HM + (size_t)(row0 + ai * HALF + m * 16) * FF + col) = w; }
    }
};

struct EpiDown {
    static constexpr bool PERM = false, AFTER_DRAIN = false; static constexpr int MID_T = 0;
    const float* X1; const float* mod; float* Y;
    __device__ __forceinline__ void operator()(const f32x4 (&acc)[2][2][4][2], const Unit& u, int ui, int wr, int wc, int fr, int fq) const {
        (void)ui;
        const int col0 = u.pn * BM + wc * 32 + 4 * fq;
#pragma unroll
        for (int ai = 0; ai < 2; ++ai)
#pragma unroll
            for (int m = 0; m < 4; ++m) { const int row = u.pm * BM + ai * HALF + wr * 64 + m * 16 + fr;
                const float* xrow = X1 + (size_t)row * D; const float* grow = mod + (size_t)mod_row(row) * NMOD + 5120;
#pragma unroll
                for (int bj = 0; bj < 2; ++bj)
#pragma unroll
                    for (int n = 0; n < 2; ++n) { const int col = col0 + bj * HALF + n * 16; const f32x4 x4 = *(const f32x4*)(xrow + col), g4 = *(const f32x4*)(grow + col);
                        *(f32x4*)(Y + (size_t)row * D + col) = x4 + g4 * acc[ai][bj][m][n]; } }
    }
};

template <class Epi, class Sched, bool ALIGN_EPI = false, bool SP2 = false>
__device__ __forceinline__ void gemm_phase(PG8_LAS unsigned char* lds, const Gemm g, const Sched& S, const Epi& E) {
    int tid_ = threadIdx.x; asm volatile("" : "+v"(tid_));
    const int tid = tid_, wid = __builtin_amdgcn_readfirstlane(tid >> 6), lane = tid & 63, wr = wid >> 2, wc = wid & 3, fr = lane & 15, fq = lane >> 4;
    const int K = g.K, nt = K / BK;
    unsigned voffA[2], voffB[2];
#pragma unroll
    for (int i = 0; i < 2; ++i) { int R, C; stage_rc(tid * 16 + i * 8192, R, C); const int Rb = Epi::PERM ? ((R & ~31) + perm32(R & 31)) : R;
        voffA[i] = (unsigned)(R * K + C) * 2u; voffB[i] = (unsigned)(Rb * K + C) * 2u; }
    const size_t kstep = (size_t)(BK * 2);
    const size_t hstep = (size_t)HALF * K * 2;
    const size_t tstep = 2 * hstep;
    const unsigned ldsw = (unsigned)wid * 1024u;
    const int aoff = lds_byte(wr * 64 + fr, fq * 8), boff = lds_byte(wc * 32 + fr, fq * 8);
#define PG8_SA(b, h) (((b) * 2 + (h)) * HTB)
#define PG8_SB(b, h) ((4 + (b) * 2 + (h)) * HTB)
#define PG8_STAGE(bufoff, gbase, voff) do { _Pragma("unroll") for (int _i = 0; _i < 2; ++_i) \
        __builtin_amdgcn_global_load_lds((const unsigned*)((const char*)(gbase) + (voff)[_i]), (PG8_LAS unsigned*)(lds + (bufoff) + ldsw + _i * 8192), 16, 0, 0); } while (0)
#define PG8_LDA(dst, b, h) do { _Pragma("unroll") for (int m = 0; m < 4; ++m) _Pragma("unroll") for (int k = 0; k < 2; ++k) dst[m][k] = *(const PG8_LAS bf16x8*)(lds + PG8_SA(b, h) + aoff + m * 2048 + k * 1024); } while (0)
#define PG8_LDB(dst, b, h) do { _Pragma("unroll") for (int n = 0; n < 2; ++n) _Pragma("unroll") for (int k = 0; k < 2; ++k) dst[n][k] = *(const PG8_LAS bf16x8*)(lds + PG8_SB(b, h) + boff + n * 2048 + k * 1024); } while (0)
#define PG8_MMA(ai, bj, At, Bt) do { __builtin_amdgcn_s_setprio(1); _Pragma("unroll") for (int m = 0; m < 4; ++m) _Pragma("unroll") for (int n = 0; n < 2; ++n) _Pragma("unroll") for (int k = 0; k < 2; ++k) \
        acc[ai][bj][m][n] = __builtin_amdgcn_mfma_f32_16x16x32_bf16(Bt[n][k], At[m][k], acc[ai][bj][m][n], 0, 0, 0); __builtin_amdgcn_s_setprio(0); } while (0)
#define PG8_WAIT_V(n) asm volatile("s_waitcnt vmcnt(" #n ")" ::: "memory")
#define PG8_WAIT_L(n) asm volatile("s_waitcnt lgkmcnt(" #n ")" ::: "memory")
#define PG8_BAR __builtin_amdgcn_s_barrier()
#define PG8_SCHED __builtin_amdgcn_sched_barrier(0)
    Unit cur, nxt; int ui = 0;
    if (!S.next(0, cur)) return;
    f32x4 acc[2][2][4][2];
#pragma unroll
    for (int a = 0; a < 2; ++a)
#pragma unroll
        for (int b = 0; b < 2; ++b)
#pragma unroll
            for (int m = 0; m < 4; ++m)
#pragma unroll
                for (int n = 0; n < 2; ++n) acc[a][b][m][n] = (f32x4){0.f, 0.f, 0.f, 0.f};
    bf16x8 At[4][2], B0[2][2], B1[2][2];
    const char* cA = (const char*)g.A + (size_t)cur.pm * tstep; const char* cB = (const char*)g.Bt + (size_t)cur.pn * tstep;
    S.a_ready(cur);
    if constexpr (SP2) {
        PG8_STAGE(PG8_SB(0, 0), cB, voffB); PG8_STAGE(PG8_SB(0, 1), cB + hstep, voffB); PG8_STAGE(PG8_SA(0, 0), cA, voffA); PG8_STAGE(PG8_SA(0, 1), cA + hstep, voffA);
        if (wr == 1) PG8_BAR;
        PG8_WAIT_V(2); PG8_BAR;
        PG8_STAGE(PG8_SB(1, 0), cB + kstep, voffB); PG8_STAGE(PG8_SA(1, 0), cA + kstep, voffA); PG8_STAGE(PG8_SB(1, 1), cB + hstep + kstep, voffB);
        PG8_WAIT_V(6); PG8_BAR;
    } else {
        PG8_STAGE(PG8_SB(0, 0), cB, voffB); PG8_STAGE(PG8_SA(0, 0), cA, voffA); PG8_STAGE(PG8_SB(0, 1), cB + hstep, voffB); PG8_STAGE(PG8_SA(0, 1), cA + hstep, voffA);
        if (wr == 1) PG8_BAR;
        PG8_WAIT_V(4); PG8_BAR;
        PG8_STAGE(PG8_SB(1, 0), cB + kstep, voffB); PG8_STAGE(PG8_SA(1, 0), cA + kstep, voffA); PG8_STAGE(PG8_SB(1, 1), cB + hstep + kstep, voffB);
        PG8_WAIT_V(6); PG8_BAR;
    }
    for (;;) {
        const bool has_next = S.next(ui + 1, nxt);
        const char* nA = has_next ? (const char*)g.A + (size_t)nxt.pm * tstep : cA; const char* nB = has_next ? (const char*)g.Bt + (size_t)nxt.pn * tstep : cB;
        for (int t = 0; t < nt; t += 2) {
            if constexpr (Epi::MID_T > 0) { if (t == Epi::MID_T) E.mid(acc, ui, wr, fr); }
            const bool last = (t == nt - 2);
            const char* a1 = cA + (size_t)(t + 1) * kstep;
            const char* a2 = last ? nA : cA + (size_t)(t + 2) * kstep; const char* b2 = last ? nB : cB + (size_t)(t + 2) * kstep;
            const char* a3 = a2 + kstep; const char* b3 = b2 + kstep;
            if (last && has_next) S.a_ready(nxt);
            if constexpr (SP2) {
            PG8_LDB(B0, 0, 0); PG8_LDB(B1, 0, 1); PG8_SCHED; PG8_LDA(At, 0, 0); PG8_STAGE(PG8_SA(1, 1), a1 + hstep, voffA);
            PG8_WAIT_V(8); PG8_WAIT_L(0); PG8_BAR; PG8_MMA(0, 0, At, B0); PG8_MMA(0, 1, At, B1); PG8_BAR; PG8_SCHED;
            PG8_LDA(At, 0, 1); PG8_STAGE(PG8_SB(0, 0), b2, voffB); PG8_STAGE(PG8_SB(0, 1), b2 + hstep, voffB); PG8_STAGE(PG8_SA(0, 0), a2, voffA);
            PG8_WAIT_V(8); PG8_WAIT_L(0); PG8_BAR; PG8_MMA(1, 0, At, B0); PG8_MMA(1, 1, At, B1); PG8_BAR; PG8_SCHED;
            PG8_LDB(B0, 1, 0); PG8_LDB(B1, 1, 1); PG8_SCHED; PG8_LDA(At, 1, 0); PG8_STAGE(PG8_SA(0, 1), a2 + hstep, voffA);
            PG8_WAIT_V(8); PG8_WAIT_L(0); PG8_BAR; PG8_MMA(0, 0, At, B0); PG8_MMA(0, 1, At, B1); PG8_BAR; PG8_SCHED;
            PG8_LDA(At, 1, 1); PG8_STAGE(PG8_SB(1, 0), b3, voffB); PG8_STAGE(PG8_SB(1, 1), b3 + hstep, voffB); PG8_STAGE(PG8_SA(1, 0), a3, voffA);
            PG8_WAIT_V(8); PG8_WAIT_L(0); PG8_BAR; PG8_MMA(1, 0, At, B0); PG8_MMA(1, 1, At, B1); PG8_BAR; PG8_SCHED;
            } else {
            PG8_LDB(B0, 0, 0); PG8_SCHED; PG8_LDA(At, 0, 0); PG8_STAGE(PG8_SA(1, 1), a1 + hstep, voffA);
            PG8_WAIT_L(8); PG8_BAR; PG8_WAIT_L(0); PG8_MMA(0, 0, At, B0); PG8_BAR; PG8_SCHED;
            PG8_LDB(B1, 0, 1); PG8_STAGE(PG8_SB(0, 0), b2, voffB);
            PG8_BAR; PG8_WAIT_L(0); PG8_MMA(0, 1, At, B1); PG8_BAR;
            PG8_LDA(At, 0, 1); PG8_STAGE(PG8_SA(0, 0), a2, voffA);
            PG8_BAR; PG8_WAIT_L(0); PG8_MMA(1, 0, At, B0); PG8_BAR; PG8_SCHED;
            PG8_STAGE(PG8_SB(0, 1), b2 + hstep, voffB);
            PG8_WAIT_V(6); PG8_BAR; PG8_MMA(1, 1, At, B1); PG8_BAR;
            PG8_LDB(B0, 1, 0); PG8_SCHED; PG8_LDA(At, 1, 0); PG8_STAGE(PG8_SA(0, 1), a2 + hstep, voffA);
            PG8_WAIT_L(8); PG8_BAR; PG8_WAIT_L(0); PG8_MMA(0, 0, At, B0); PG8_BAR; PG8_SCHED;
            PG8_LDB(B1, 1, 1); PG8_STAGE(PG8_SB(1, 0), b3, voffB);
            PG8_BAR; PG8_WAIT_L(0); PG8_MMA(0, 1, At, B1); PG8_BAR;
            PG8_LDA(At, 1, 1); PG8_STAGE(PG8_SA(1, 0), a3, voffA);
            PG8_BAR; PG8_WAIT_L(0); PG8_MMA(1, 0, At, B0); PG8_BAR; PG8_SCHED;
            PG8_STAGE(PG8_SB(1, 1), b3 + hstep, voffB);
            PG8_WAIT_V(6); PG8_BAR; PG8_MMA(1, 1, At, B1); PG8_BAR;
            }
        }
        if constexpr (ALIGN_EPI) { if (wr == 0) PG8_BAR; }
        if constexpr (!Epi::AFTER_DRAIN) { E(acc, cur, ui, wr, wc, fr, fq); S.done(cur); }
        if (!has_next) break;
#pragma unroll
        for (int a = 0; a < 2; ++a)
#pragma unroll
            for (int b = 0; b < 2; ++b)
#pragma unroll
                for (int m = 0; m < 4; ++m)
#pragma unroll
                    for (int n = 0; n < 2; ++n) acc[a][b][m][n] = (f32x4){0.f, 0.f, 0.f, 0.f};
        cur = nxt; cA = nA; cB = nB; ++ui;
        if constexpr (ALIGN_EPI) { if (wr == 1) PG8_BAR; }
    }
    PG8_WAIT_V(0);
    if constexpr (!ALIGN_EPI) { if (wr == 0) PG8_BAR; }
    PG8_BAR;
    if constexpr (Epi::AFTER_DRAIN) { E.fused(acc, cur, wr, wc, fr, fq, lds, wid, lane); S.done(cur); }
#undef PG8_SA
#undef PG8_SB
#undef PG8_STAGE
#undef PG8_LDA
#undef PG8_LDB
#undef PG8_MMA
#undef PG8_WAIT_V
#undef PG8_WAIT_L
#undef PG8_BAR
#undef PG8_SCHED
}
}
#define GAS __attribute__((address_space(1)))
#define LAS __attribute__((address_space(3)))
typedef unsigned short bf16;
typedef unsigned v4u __attribute__((ext_vector_type(4)));
typedef float f32x4 __attribute__((ext_vector_type(4)));
typedef short bf16x8 __attribute__((ext_vector_type(8)));
typedef GAS unsigned gu32;
typedef GAS unsigned long long gu64;
#define RLX_AGENT __ATOMIC_RELAXED, __HIP_MEMORY_SCOPE_AGENT
#define LDS_WAIT() asm volatile("s_waitcnt lgkmcnt(0)" ::: "memory")
#define VM_WAIT() asm volatile("s_waitcnt vmcnt(0)" ::: "memory")
__device__ __forceinline__ unsigned long long rt() { return __builtin_amdgcn_s_memrealtime(); }
__device__ __forceinline__ unsigned f2bf(float f) { unsigned u = __builtin_bit_cast(unsigned, f); return (u + 0x7fffu + ((u >> 16) & 1u)) >> 16; }
__device__ __forceinline__ unsigned pk2(float lo, float hi) { return f2bf(lo) | (f2bf(hi) << 16); }

#define XB_TMO      128
#define XB_XCNT(j)  (256  + 64 * (j))
#define XB_XSUB(j)  (1280 + 64 * (j))
#define XB_XGEN(j)  (2304 + 64 * (j))
#define XB_TOP      3328
#define XB_TOPGEN   3392
#define XCD_BAR_WORDS 3456
#define XB_SPIN_CAP (1u << 18)

__device__ __forceinline__ unsigned xb_ld(unsigned* p)              { return __hip_atomic_load(p, __ATOMIC_RELAXED, __HIP_MEMORY_SCOPE_AGENT); }
__device__ __forceinline__ unsigned xb_add(unsigned* p, unsigned v) { return __hip_atomic_fetch_add(p, v, __ATOMIC_RELAXED, __HIP_MEMORY_SCOPE_AGENT); }
__device__ __forceinline__ unsigned xb_xcc_id() { return (unsigned)__builtin_amdgcn_s_getreg((3 << 11) | 20) & 0xFu; }
#define XB_SPIN(cond, bar) do { unsigned _sp = 0; while (cond) { __builtin_amdgcn_s_sleep(1); \
    if ((++_sp & 255u) == 0u) { if (xb_ld(&(bar)[XB_TMO])) break; if (_sp > XB_SPIN_CAP) { atomicAdd(&(bar)[XB_TMO], 1u); break; } } } } while (0)

struct XcdBarrier {
    unsigned* bar; unsigned x;
    volatile LAS unsigned* st;
};

__device__ __forceinline__ XcdBarrier xcd_barrier_post(unsigned* bar, volatile LAS unsigned* st) {
    XcdBarrier b; b.bar = bar; b.x = xb_xcc_id(); b.st = st;
    if (threadIdx.x == 0) (void)xb_add(&bar[XB_XCNT(b.x)], 1u);
    return b;
}
__device__ __forceinline__ void xcd_barrier_complete(unsigned* bar, unsigned x, unsigned& nloc, unsigned& nx) {
    const unsigned G = gridDim.x * gridDim.y * gridDim.z;
    unsigned sum, cnt, mine, sp = 0u;
    for (;;) {
        sum = 0u; cnt = 0u; mine = 0u;
#pragma unroll
        for (unsigned j = 0; j < 16; ++j) { const unsigned c = xb_ld(&bar[XB_XCNT(j)]); sum += c; cnt += (c > 0u) ? 1u : 0u; mine = (j == x) ? c : mine; }
        if (sum == G) break;
        __builtin_amdgcn_s_sleep(1);
        if ((++sp & 255u) == 0u) { if (xb_ld(&bar[XB_TMO])) break; if (sp > XB_SPIN_CAP) { atomicAdd(&bar[XB_TMO], 1u); break; } }
    }
    nloc = mine > 0u ? mine : 1u; nx = cnt > 0u ? cnt : 1u;
}

__device__ __forceinline__ void xcd_barrier(const XcdBarrier& b) {
    asm volatile("s_waitcnt vmcnt(0)" ::: "memory");
    __syncthreads();
    if (threadIdx.x == 0) {
        unsigned* bar = b.bar;
        __builtin_amdgcn_s_waitcnt(0);
        unsigned nloc = b.st[0], nx = b.st[1];
        if (nloc == 0u) { xcd_barrier_complete(bar, b.x, nloc, nx); b.st[0] = nloc; b.st[1] = nx; }
        const unsigned old = xb_add(&bar[XB_XSUB(b.x)], 1u);
        const unsigned gen = old / nloc;
        if (old + 1u == (gen + 1u) * nloc) {
            __builtin_amdgcn_fence(__ATOMIC_RELEASE, "agent");
            asm volatile("s_waitcnt vmcnt(0)" ::: "memory");
            const unsigned og = xb_add(&bar[XB_TOP], 1u);
            const unsigned tg = og / nx;
            if (og + 1u == (tg + 1u) * nx) xb_add(&bar[XB_TOPGEN], 1u);
            else XB_SPIN(xb_ld(&bar[XB_TOPGEN]) == tg, bar);
            __builtin_amdgcn_fence(__ATOMIC_ACQUIRE, "agent");
            xb_add(&bar[XB_XGEN(b.x)], 1u);
            asm volatile("s_waitcnt vmcnt(0)" ::: "memory");
        } else {
            XB_SPIN(xb_ld(&bar[XB_XGEN(b.x)]) == gen, bar);
            __builtin_amdgcn_fence(__ATOMIC_ACQUIRE, "agent");
            asm volatile("s_waitcnt vmcnt(0)" ::: "memory");
        }
    }
    __syncthreads();
}


constexpr size_t MiB = 1u << 20;
constexpr size_t WS_CTL = 0, CTL_ZERO_BYTES = 1 * MiB;
constexpr size_t WS_MOD = 1 * MiB;
constexpr size_t WS_COS = 5 * MiB, WS_SIN = 7 * MiB;
constexpr size_t WS_SSQ = 9 * MiB;
constexpr size_t WS_WIN = 12 * MiB, WS_WO = 17 * MiB, WS_WGU = 20 * MiB, WS_WD = 32 * MiB;
constexpr size_t WS_XN = 40 * MiB;
constexpr size_t WS_QKV = 76 * MiB;
constexpr size_t WS_OB = 152 * MiB;
constexpr size_t WS_X1 = 186 * MiB;
constexpr size_t WS_HM = 256 * MiB;
constexpr size_t WS_END = 348 * MiB;
static_assert(WS_MOD + (size_t)NMB * NMOD * 4 <= WS_COS && WS_COS + (size_t)NPOS * 32 * 4 <= WS_SIN && WS_SIN + (size_t)NPOS * 32 * 4 <= WS_SSQ && WS_SSQ + (size_t)MT * 16 * 4 <= WS_WIN, "ws map 1");
static_assert(WS_WIN + (size_t)INC * D * 2 <= WS_WO && WS_WO + (size_t)D * D * 2 <= WS_WGU && WS_WGU + (size_t)2 * FF * D * 2 <= WS_WD && WS_WD + (size_t)D * FF * 2 <= WS_XN, "ws map 2");
static_assert(WS_XN + (size_t)MT * D * 2 <= WS_QKV && WS_QKV + (size_t)MT * INC * 2 <= WS_OB && WS_OB + (size_t)MT * D * 2 <= WS_X1 && WS_X1 + (size_t)MT * D * 4 <= WS_HM && WS_HM + (size_t)MT * FF * 2 <= WS_END, "ws map 3");
constexpr int CW_TMO = 0, CW_BAR = 4096;

constexpr int RING_OFF = 0, RING_BYTES = 131072;
constexpr int LDSCTL_OFF = RING_BYTES, MISC_OFF = LDSCTL_OFF + 320, TAB_OFF = LDSCTL_OFF + 1024;
constexpr int LDS_BYTES = 147456;
static_assert(TAB_OFF + 4096 <= LDS_BYTES, "LDS map");
constexpr int NWAVES = 8, NTHREADS = NWAVES * 64;

typedef float f32x16 __attribute__((ext_vector_type(16)));
typedef short s16x4 __attribute__((ext_vector_type(4)));
typedef short v4i16_t __attribute__((ext_vector_type(4)));
typedef unsigned u32x2 __attribute__((ext_vector_type(2)));
typedef float f32x2 __attribute__((ext_vector_type(2)));

__device__ __forceinline__ float bf2f(unsigned h) { return __uint_as_float(h << 16); }
__device__ __forceinline__ float wave_sum(float v) {
#pragma unroll
    for (int o = 1; o < 64; o <<= 1) v += __shfl_xor(v, o);
    return v;
}
__device__ __forceinline__ float ex2(float x) { return __builtin_amdgcn_exp2f(x); }

__device__ __forceinline__ void split8(const float (&v)[8], bf16x8& hi, bf16x8& lo) {
#pragma unroll
    for (int i = 0; i < 8; ++i) { const unsigned h = f2bf(v[i]); hi[i] = (short)h; lo[i] = (short)f2bf(v[i] - bf2f(h)); }
}
__device__ __forceinline__ float silu_f(float x) { return x / (1.0f + ex2(-LOG2E * x)); }
__device__ __forceinline__ void ada_block(LAS unsigned char* lds, int ct, const float* cp, const float* cs, const float* w_ada, const float* b_ada, float* mod, int tid, int wave, int lane) {
    const int n0 = 32 * ct, ln = lane & 31, hi = lane >> 5;
    f32x16 acc[5];
#pragma unroll
    for (int rt = 0; rt < 5; ++rt)
#pragma unroll
        for (int r = 0; r < 16; ++r) acc[rt][r] = 0.f;
#pragma unroll 1
    for (int ks = 0; ks < 8; ++ks) {
        const int kb = 128 * wave + 16 * ks + 8 * hi;
        float bv[8];
#pragma unroll
        for (int i = 0; i < 8; ++i) bv[i] = w_ada[(size_t)(kb + i) * NMOD + n0 + ln];
        bf16x8 bh, bl; split8(bv, bh, bl);
#pragma unroll
        for (int rt = 0; rt < 5; ++rt) {
            const int row = 32 * rt + ln;
            float av[8];
            if (row < NMB) { const float* c = (row < NB ? cp + (size_t)row * D : cs + (size_t)(row - NB) * D) + kb;
                const f32x4 c0 = *(const f32x4*)c, c1 = *(const f32x4*)(c + 4);
                av[0] = silu_f(c0[0]); av[1] = silu_f(c0[1]); av[2] = silu_f(c0[2]); av[3] = silu_f(c0[3]); av[4] = silu_f(c1[0]); av[5] = silu_f(c1[1]); av[6] = silu_f(c1[2]); av[7] = silu_f(c1[3]);
            } else {
#pragma unroll
                for (int i = 0; i < 8; ++i) av[i] = 0.f;
            }
            bf16x8 ah, al; split8(av, ah, al);
            acc[rt] = __builtin_amdgcn_mfma_f32_32x32x16_bf16(ah, bh, acc[rt], 0, 0, 0);
            acc[rt] = __builtin_amdgcn_mfma_f32_32x32x16_bf16(ah, bl, acc[rt], 0, 0, 0);
            acc[rt] = __builtin_amdgcn_mfma_f32_32x32x16_bf16(al, bh, acc[rt], 0, 0, 0);
        }
    }
    LAS float* red = (LAS float*)lds;
#pragma unroll
    for (int rt = 0; rt < 5; ++rt) {
#pragma unroll
        for (int r = 0; r < 16; ++r) red[(wave * 16 + r) * 64 + lane] = acc[rt][r];
        __syncthreads();
#pragma unroll
        for (int x = 0; x < 2; ++x) { const int e = tid + 512 * x, r = e >> 6, l2 = e & 63; float s = 0.f;
#pragma unroll
            for (int w = 0; w < 8; ++w) s += red[(w * 16 + r) * 64 + l2];
            const int mrow = 32 * rt + (r & 3) + 8 * (r >> 2) + 4 * (l2 >> 5), col = n0 + (l2 & 31);
            if (mrow < NMB) mod[(size_t)mrow * NMOD + col] = s + b_ada[col]; }
        __syncthreads();
    }
}

template <class RowMap>
__device__ __forceinline__ void transpose_item(const float* W, int K, int N, bf16* WT, RowMap rm, const float* sc_a, const float* sc_b, LAS float* scr, int item, int lane) {
    const int nblk = N / 32, kb = item / nblk, nb = item % nblk, k0 = 64 * kb, n0 = 32 * nb;
#pragma unroll 8
    for (int i = 0; i < 32; ++i) { const int kk = 2 * i + (lane >> 5); float v = W[(size_t)(k0 + kk) * N + n0 + (lane & 31)];
        if (sc_a) { const int k = k0 + kk; v *= (k < 512 ? sc_a[k] : sc_b[k - 512]); }
        scr[kk * 33 + (lane & 31)] = v; }
    LDS_WAIT(); asm volatile("" ::: "memory");
    const int c = lane & 7;
#pragma unroll
    for (int j = 0; j < 4; ++j) { const int n = (lane >> 3) + 8 * j; const LAS float* s = scr + (8 * c) * 33 + n;
        v4u o; o.x = pk2(s[0 * 33], s[1 * 33]); o.y = pk2(s[2 * 33], s[3 * 33]); o.z = pk2(s[4 * 33], s[5 * 33]); o.w = pk2(s[6 * 33], s[7 * 33]);
        *(GAS v4u*)(WT + (size_t)rm(n0 + n) * K + k0 + 8 * c) = o; }
    LDS_WAIT(); asm volatile("" ::: "memory");
}
struct RmIn { __device__ __forceinline__ int operator()(int n) const { const int h64 = n >> 6, e = n & 63; const bool rot = h64 < 10 || (h64 >= 12 && h64 < 28);
    return rot ? (n & ~63) + 8 * ((e & 31) >> 2) + (e & 3) + 4 * (e >> 5) : n; } };
struct RmId { __device__ __forceinline__ int operator()(int n) const { return n; } };
struct RmGate { __device__ __forceinline__ int operator()(int n) const { return 256 * (n >> 7) + (n & 127); } };
struct RmUp { __device__ __forceinline__ int operator()(int n) const { return 256 * (n >> 7) + 128 + (n & 127); } };

__device__ __forceinline__ void rope_entry(int e, float* COS, float* SIN) {
    const int pos = e >> 5, i = e & 31;
    double inv = 1.0; for (int k = 0; k < i; ++k) inv *= 0.74989420933245582730;
    const double rev = (double)pos * inv * 0.15915494309189533577;
    const double fr = rev - __builtin_rint(rev);
    const double qd = __builtin_rint(fr * 4.0);
    const double z = (fr - qd * 0.25) * 6.28318530717958647693, z2 = z * z;
    const double s = z * (1.0 + z2 * (-1.0 / 6 + z2 * (1.0 / 120 + z2 * (-1.0 / 5040 + z2 * (1.0 / 362880 + z2 * (-1.0 / 39916800 + z2 * (1.0 / 6227020800.0)))))));
    const double c = 1.0 + z2 * (-0.5 + z2 * (1.0 / 24 + z2 * (-1.0 / 720 + z2 * (1.0 / 40320 + z2 * (-1.0 / 3628800 + z2 * (1.0 / 479001600.0))))));
    const int q = ((int)qd) & 3;
    const double sn = q == 0 ? s : q == 1 ? c : q == 2 ? -s : -c;
    const double cs = q == 0 ? c : q == 1 ? -s : q == 2 ? -c : s;
    COS[e] = (float)cs; SIN[e] = (float)sn;
}

__device__ __forceinline__ void normmod_row(const float* xrow, const float* g, const float* sh, const float* sc, bf16* orow, int lane) {
    const GAS f32x4* xr = (const GAS f32x4*)xrow + lane;
    f32x4 v[4]; float s = 0.f;
#pragma unroll
    for (int j = 0; j < 4; ++j) { v[j] = xr[64 * j]; s += (v[j].x * v[j].x + v[j].y * v[j].y) + (v[j].z * v[j].z + v[j].w * v[j].w); }
    const float rstd = 1.f / sqrtf(wave_sum(s) * (1.f / D) + EPS);
    GAS unsigned long long* o8 = (GAS unsigned long long*)orow + lane;
#pragma unroll
    for (int j = 0; j < 4; ++j) { const f32x4 gg = ((const GAS f32x4*)g)[lane + 64 * j], hh = ((const GAS f32x4*)sh)[lane + 64 * j], cc = ((const GAS f32x4*)sc)[lane + 64 * j];
        const f32x4 o = v[j] * rstd * gg * (cc + 1.0f) + hh;
        o8[64 * j] = (unsigned long long)pk2(o.x, o.y) | ((unsigned long long)pk2(o.z, o.w) << 32); }
}
__device__ __forceinline__ void final_row(float* xrow, const float* g, int lane) {
    GAS f32x4* xr = (GAS f32x4*)xrow + lane;
    f32x4 v[4]; float s = 0.f;
#pragma unroll
    for (int j = 0; j < 4; ++j) { v[j] = xr[64 * j]; s += (v[j].x * v[j].x + v[j].y * v[j].y) + (v[j].z * v[j].z + v[j].w * v[j].w); }
    const float rstd = 1.f / sqrtf(wave_sum(s) * (1.f / D) + EPS);
#pragma unroll
    for (int j = 0; j < 4; ++j) xr[64 * j] = v[j] * rstd * ((const GAS f32x4*)g)[lane + 64 * j];
}

__device__ __forceinline__ s16x4 vtr(const LAS unsigned char* p) { return __builtin_bit_cast(s16x4, __builtin_amdgcn_ds_read_tr16_b64_v4i16((LAS v4i16_t*)p)); }
__device__ __forceinline__ unsigned cvtpk(float lo, float hi) { return pk2(lo, hi); }

template <bool SINK>
__device__ __forceinline__ void attn_wave_tile(const bf16* __restrict__ QKV, int rowbase, int dil, int r, int m0, int qcol, int kcol, int vcol, float sink2, LAS unsigned char* vst, int lane,
                                               float& m_out, float& l_out, f32x16& o0, f32x16& o1) {
    constexpr int MAXD = SINK ? WA - 1 : 128;
    const int i = lane & 31, hi = lane >> 5;
    bf16x8 qf[4];
    { const bf16* qp = QKV + (size_t)(rowbase + (m0 + i) * dil + r) * INC + qcol + 32 * hi;
#pragma unroll
      for (int s = 0; s < 4; ++s) qf[s] = *(const bf16x8*)(qp + 8 * s); }
    float mrun = SINK ? sink2 : -INFINITY, lrun = SINK ? (hi == 0 ? 1.f : 0.f) : 0.f;
#pragma unroll
    for (int x = 0; x < 16; ++x) { o0[x] = 0.f; o1[x] = 0.f; }
    const int tr_off = (4 * hi + ((lane & 15) >> 2)) * 128 + (16 * ((lane >> 4) & 1) + 4 * (lane & 3)) * 2;
#pragma unroll 1
    for (int kt = 4; kt >= 0; --kt) {
        const int mk0 = m0 - 128 + 32 * kt;
        if (mk0 + 31 < 0) break;
        bf16x8 kf[4];
        { int mk = mk0 + i; mk = mk < 0 ? 0 : mk;
          const bf16* kp = QKV + (size_t)(rowbase + mk * dil + r) * INC + kcol + 32 * hi;
#pragma unroll
          for (int s = 0; s < 4; ++s) kf[s] = *(const bf16x8*)(kp + 8 * s); }
        v4u vv[4];
#pragma unroll
        for (int it = 0; it < 4; ++it) { int mv = mk0 + (lane >> 3) + 8 * it; mv = mv < 0 ? 0 : mv;
            vv[it] = *(const v4u*)(QKV + (size_t)(rowbase + mv * dil + r) * INC + vcol + 8 * (lane & 7)); }
        f32x16 s;
#pragma unroll
        for (int x = 0; x < 16; ++x) s[x] = 0.f;
#pragma unroll
        for (int ss = 0; ss < 4; ++ss) s = __builtin_amdgcn_mfma_f32_32x32x16_bf16(kf[ss], qf[ss], s, 0, 0, 0);
        asm volatile("" ::: "memory");
#pragma unroll
        for (int it = 0; it < 4; ++it) *(LAS v4u*)(vst + ((lane >> 3) + 8 * it) * 128 + (lane & 7) * 16) = vv[it];
        asm volatile("s_waitcnt lgkmcnt(0)" ::: "memory");
        const int dbase = 128 - 32 * kt + i;
        float mx = -INFINITY;
#pragma unroll
        for (int x = 0; x < 16; ++x) { const int j = (x & 3) + 8 * (x >> 2) + 4 * hi; const int dist = dbase - j;
            const bool ok = dist >= 0 && dist <= MAXD && (mk0 + j) >= 0;
            s[x] = ok ? s[x] : -INFINITY; mx = fmaxf(mx, s[x]); }
        mx = fmaxf(mx, __shfl_xor(mx, 32));
        const float mn = fmaxf(mrun, mx);
        const float corr = ex2(mrun - mn);
        float ps = 0.f;
#pragma unroll
        for (int x = 0; x < 16; ++x) { s[x] = ex2(s[x] - mn); ps += s[x]; }
        lrun = lrun * corr + ps; mrun = mn;
        o0 = o0 * corr; o1 = o1 * corr;
        v4u p0u, p1u;
        p0u.x = cvtpk(s[0], s[1]); p0u.y = cvtpk(s[2], s[3]); p0u.z = cvtpk(s[4], s[5]); p0u.w = cvtpk(s[6], s[7]);
        p1u.x = cvtpk(s[8], s[9]); p1u.y = cvtpk(s[10], s[11]); p1u.z = cvtpk(s[12], s[13]); p1u.w = cvtpk(s[14], s[15]);
        const bf16x8 pa0 = __builtin_bit_cast(bf16x8, p0u), pa1 = __builtin_bit_cast(bf16x8, p1u);
#pragma unroll
        for (int dt = 0; dt < 2; ++dt) {
#pragma unroll
            for (int j = 0; j < 2; ++j) {
                const LAS unsigned char* a = vst + tr_off + j * 16 * 128 + dt * 64;
                const s16x4 lo = vtr(a), hh = vtr(a + 8 * 128);
                const bf16x8 vf = (bf16x8){lo[0], lo[1], lo[2], lo[3], hh[0], hh[1], hh[2], hh[3]};
                if (dt == 0) o0 = __builtin_amdgcn_mfma_f32_32x32x16_bf16(vf, j == 0 ? pa0 : pa1, o0, 0, 0, 0);
                else         o1 = __builtin_amdgcn_mfma_f32_32x32x16_bf16(vf, j == 0 ? pa0 : pa1, o1, 0, 0, 0);
            }
        }
        asm volatile("" ::: "memory");
    }
    l_out = lrun + __shfl_xor(lrun, 32); m_out = mrun;
}

__device__ __forceinline__ void finalize_store(const f32x16& o0, const f32x16& o1, float l, bf16* orow, float* ssqp, int hi) {
    const float inv = 1.0f / l; float ss = 0.f;
#pragma unroll
    for (int dt = 0; dt < 2; ++dt)
#pragma unroll
        for (int gq = 0; gq < 4; ++gq) {
            const float a = (dt == 0 ? o0[4 * gq] : o1[4 * gq]) * inv, b = (dt == 0 ? o0[4 * gq + 1] : o1[4 * gq + 1]) * inv, c = (dt == 0 ? o0[4 * gq + 2] : o1[4 * gq + 2]) * inv, d = (dt == 0 ? o0[4 * gq + 3] : o1[4 * gq + 3]) * inv;
            ss += (a * a + b * b) + (c * c + d * d);
            u32x2 w; w.x = pk2(a, b); w.y = pk2(c, d);
            *(u32x2*)(orow + 32 * dt + 8 * gq + 4 * hi) = w; }
    ss += __shfl_xor(ss, 32);
    if (hi == 0) *ssqp = ss;
}

struct SSt { float m, l; f32x4 o; };
__device__ __forceinline__ void s_step(SSt& st, const f32x4& q4, const f32x4& k4, const f32x4& v4, bool valid) {
    float s = (q4.x * k4.x + q4.y * k4.y) + (q4.z * k4.z + q4.w * k4.w);
    s += __shfl_xor(s, 1); s += __shfl_xor(s, 2); s += __shfl_xor(s, 4); s += __shfl_xor(s, 8);
    s = valid ? s : -INFINITY;
    const float mn = fmaxf(st.m, s);
    const float corr = (mn == -INFINITY) ? 1.f : ex2(st.m - mn);
    const float p = valid ? ex2(s - mn) : 0.f;
    st.l = st.l * corr + p; st.o = st.o * corr + v4 * p; st.m = mn;
}
__device__ __forceinline__ void s_merge(SSt& st) {
#pragma unroll
    for (int x = 16; x <= 32; x <<= 1) {
        const float m2 = __shfl_xor(st.m, x), l2 = __shfl_xor(st.l, x);
        f32x4 o2; o2.x = __shfl_xor(st.o.x, x); o2.y = __shfl_xor(st.o.y, x); o2.z = __shfl_xor(st.o.z, x); o2.w = __shfl_xor(st.o.w, x);
        const float mn = fmaxf(st.m, m2);
        const float a = (st.m == -INFINITY) ? 0.f : ex2(st.m - mn), b = (m2 == -INFINITY) ? 0.f : ex2(m2 - mn);
        st.l = st.l * a + l2 * b; st.o = st.o * a + o2 * b; st.m = mn;
    }
}
__device__ __forceinline__ f32x4 load_q4(const bf16* QKV, int row, int qcol, int c) {
    const u32x2 w = *(const u32x2*)(QKV + (size_t)row * INC + qcol + 8 * (c & 7) + 4 * (c >> 3));
    f32x4 q; q.x = bf2f(w.x & 0xffffu); q.y = bf2f(w.x >> 16); q.z = bf2f(w.y & 0xffffu); q.w = bf2f(w.y >> 16); return q;
}
__device__ __forceinline__ void s_store(const SSt& st, bf16* orow, float* ssqp, int lane) {
    const int c = lane & 15; const float inv = 1.0f / st.l; const f32x4 o = st.o * inv;
    float ss = (o.x * o.x + o.y * o.y) + (o.z * o.z + o.w * o.w);
    ss += __shfl_xor(ss, 1); ss += __shfl_xor(ss, 2); ss += __shfl_xor(ss, 4); ss += __shfl_xor(ss, 8);
    if (lane < 16) { u32x2 w; w.x = pk2(o.x, o.y); w.y = pk2(o.z, o.w); *(u32x2*)(orow + 4 * c) = w; }
    if (lane == 0) *ssqp = ss;
}

#ifndef PH_MASK
#define PH_MASK 0x1ff
#endif
struct Args { const float* in[21]; float* out; unsigned char* ws; };
__global__ void __launch_bounds__(NTHREADS, 2) mk_fwd(Args args) {
    extern __shared__ __attribute__((aligned(16))) unsigned char lds_raw[];
    LAS unsigned char* lds = (LAS unsigned char*)lds_raw;
    volatile LAS unsigned* MISC = (volatile LAS unsigned*)(lds + MISC_OFF);
    const int tid = threadIdx.x, lane = tid & 63, wave = __builtin_amdgcn_readfirstlane(tid >> 6);
    const int G = gridDim.x, bx = blockIdx.x;
    const int gw = bx * NWAVES + wave, NGW = G * NWAVES;
    unsigned char* ws = args.ws;
    gu32* ctl = (gu32*)(ws + WS_CTL);
    const float* xp = args.in[0]; const float* xs = args.in[1]; const float* cp = args.in[2]; const float* cs = args.in[3];
    const float* cak = args.in[4]; const float* cav = args.in[5]; const float* cbk = args.in[6]; const float* cbv = args.in[7];
    const float* w_ada = args.in[8]; const float* b_ada = args.in[9]; const float* g_attn = args.in[10]; const float* w_in = args.in[11];
    const float* sinks = args.in[12]; const float* g_oa = args.in[13]; const float* g_ob = args.in[14]; const float* w_o = args.in[15];
    const float* g_ffn = args.in[16]; const float* w_gate = args.in[17]; const float* w_up = args.in[18]; const float* w_down = args.in[19];
    const float* g_final = args.in[20];
    float* out = args.out;
    float* MOD = (float*)(ws + WS_MOD); float* COS = (float*)(ws + WS_COS); float* SIN = (float*)(ws + WS_SIN); float* SSQ = (float*)(ws + WS_SSQ);
    bf16* Win_t = (bf16*)(ws + WS_WIN); bf16* Wo_t = (bf16*)(ws + WS_WO); bf16* Wgu_t = (bf16*)(ws + WS_WGU); bf16* Wd_t = (bf16*)(ws + WS_WD);
    bf16* XN = (bf16*)(ws + WS_XN); bf16* QKV = (bf16*)(ws + WS_QKV); bf16* OB = (bf16*)(ws + WS_OB); float* X1 = (float*)(ws + WS_X1); bf16* HM = (bf16*)(ws + WS_HM);

    for (int u = tid; u < (LDS_BYTES - LDSCTL_OFF) / 4; u += NTHREADS) ((LAS unsigned*)(lds + LDSCTL_OFF))[u] = 0u;
    __syncthreads();
    XcdBarrier bar = xcd_barrier_post((unsigned*)(ctl + CW_BAR), MISC + 8);

#if (PH_MASK >> 0) & 1
    if (bx < NMOD / 32) ada_block(lds, bx, cp, cs, w_ada, b_ada, MOD, tid, wave, lane);
    {
        LAS float* scr = (LAS float*)(lds + RING_OFF + wave * 16384);
        constexpr int I_IN = (D / 64) * (INC / 32), I_O = (D / 64) * (D / 32), I_G = (D / 64) * (FF / 32), I_D = (FF / 64) * (D / 32);
        constexpr int NITEMS = I_IN + I_O + 2 * I_G + I_D;
        for (int it = gw; it < NITEMS; it += NGW) {
            int r = it;
            if (r < I_IN) { transpose_item(w_in, D, INC, Win_t, RmIn(), nullptr, nullptr, scr, r, lane); continue; } r -= I_IN;
            if (r < I_O) { transpose_item(w_o, D, D, Wo_t, RmId(), g_oa, g_ob, scr, r, lane); continue; } r -= I_O;
            if (r < I_G) { transpose_item(w_gate, D, FF, Wgu_t, RmGate(), nullptr, nullptr, scr, r, lane); continue; } r -= I_G;
            if (r < I_G) { transpose_item(w_up, D, FF, Wgu_t, RmUp(), nullptr, nullptr, scr, r, lane); continue; } r -= I_G;
            transpose_item(w_down, FF, D, Wd_t, RmId(), nullptr, nullptr, scr, r, lane);
        }
        for (int e = bx * NTHREADS + tid; e < NPOS * 32; e += G * NTHREADS) rope_entry(e, COS, SIN);
        {
            const int gt = bx * NTHREADS + tid, NT = G * NTHREADS;
            constexpr int PB = (WB - DS) * 512 / 4, PA = (WA - DS) * 128 / 4;
            for (int b = 0; b < DB; ++b) {
                const f32x4* sk = (const f32x4*)(cbk + (size_t)b * WB * 512 + DS * 512); const f32x4* sv = (const f32x4*)(cbv + (size_t)b * WB * 512 + DS * 512);
                f32x4* dk = (f32x4*)(out + O_SBK + (size_t)b * WB * 512); f32x4* dv = (f32x4*)(out + O_SBV + (size_t)b * WB * 512);
                for (int i = gt; i < PB; i += NT) { dk[i] = sk[i]; dv[i] = sv[i]; }
            }
            for (int b = 0; b < DB; ++b) {
                const f32x4* sk = (const f32x4*)(cak + (size_t)b * WA * 128 + DS * 128); const f32x4* sv = (const f32x4*)(cav + (size_t)b * WA * 128 + DS * 128);
                f32x4* dk = (f32x4*)(out + O_SAK + (size_t)b * WA * 128); f32x4* dv = (f32x4*)(out + O_SAV + (size_t)b * WA * 128);
                for (int i = gt; i < PA; i += NT) { dk[i] = sk[i]; dv[i] = sv[i]; }
            }
        }
    }
#endif
    xcd_barrier(bar);

#if (PH_MASK >> 1) & 1
    for (int row = gw; row < MT; row += NGW) {
        const float* xrow = row < MP ? xp + (size_t)row * D : xs + (size_t)(row - MP) * D; const float* mr = MOD + (size_t)mod_row(row) * NMOD;
        normmod_row(xrow, g_attn, mr, mr + 1024, XN + (size_t)row * D, lane);
    }
#endif
    xcd_barrier(bar);

#if (PH_MASK >> 2) & 1
    {
        pg8::Gemm g{XN, Win_t, MT, INC, D}; pg8::StaticOrder S; S.init(MT, INC, G, bx);
        pg8::EpiQKV E{QKV, COS, SIN, out};
        pg8::gemm_phase<pg8::EpiQKV, pg8::StaticOrder, true, true>(lds + RING_OFF, g, S, E);
    }
#endif
    xcd_barrier(bar);

#if (PH_MASK >> 3) & 1
    {
        LAS unsigned char* Ost = lds;
        LAS f32x2* ML = (LAS f32x2*)(lds + 65536);
        LAS unsigned char* vst = lds + 73728 + wave * 4096;
        const int i = lane & 31, hi = lane >> 5;
#if !defined(NO_PROMPT)
        for (int unit = bx; unit < 256; unit += G) {
            const int hq = unit & 7, R = (unit >> 3) & 15, b = unit >> 7;
            const float sink2 = sinks[hq] * LOG2E;
#pragma unroll 1
            for (int k = 0; k < 2; ++k) { const int m0 = 512 * R + 32 * (wave + 8 * k);
                float m, l; f32x16 o0, o1;
                attn_wave_tile<true>(QKV, b * SEQ, 1, 0, m0, 64 * hq, 512 + 64 * (hq >> 2), 640 + 64 * (hq >> 2), sink2, vst, lane, m, l, o0, o1);
                const int row = b * SEQ + m0 + i;
                finalize_store(o0, o1, l, OB + (size_t)row * D + 64 * hq, SSQ + (size_t)row * 16 + hq, hi); }
        }
        for (int unit = bx; unit < 256; unit += G) {
            const int hb = unit & 7, R = (unit >> 3) & 15, b = unit >> 7;
#pragma unroll 1
            for (int br = 0; br < 3; ++br) {
                const int dil = br == 0 ? 1 : br == 1 ? 4 : 16;
#pragma unroll 1
                for (int k = 0; k < 2; ++k) { const int ti = wave + 8 * k;
                    const int r = br == 0 ? 0 : br == 1 ? (ti >> 2) : ti;
                    const int m0 = br == 0 ? 512 * R + 32 * ti : br == 1 ? 128 * R + 32 * (ti & 3) : 32 * R;
                    float m, l; f32x16 o0, o1;
                    attn_wave_tile<false>(QKV, b * SEQ, dil, r, m0, 768 + 64 * hb, 1280 + 64 * hb, 1792 + 64 * hb, 0.f, vst, lane, m, l, o0, o1);
                    const int t = (m0 + i) * dil + r, ql = t - 512 * R;
                    LAS unsigned char* orow = Ost + ql * 128 + 8 * hi;
                    if (br > 0) {
                        const f32x2 ms = ML[ql]; const float mn = fmaxf(ms.x, m), a = ex2(ms.x - mn), c = ex2(m - mn);
                        l = ms.y * a + l * c; m = mn;
#pragma unroll
                        for (int dt = 0; dt < 2; ++dt)
#pragma unroll
                            for (int gq = 0; gq < 4; ++gq) { const u32x2 w = *(const LAS u32x2*)(orow + (32 * dt + 8 * gq) * 2);
                                const float s0 = bf2f(w.x & 0xffffu), s1 = bf2f(w.x >> 16), s2 = bf2f(w.y & 0xffffu), s3 = bf2f(w.y >> 16);
                                if (dt == 0) { o0[4 * gq] = o0[4 * gq] * c + s0 * a; o0[4 * gq + 1] = o0[4 * gq + 1] * c + s1 * a; o0[4 * gq + 2] = o0[4 * gq + 2] * c + s2 * a; o0[4 * gq + 3] = o0[4 * gq + 3] * c + s3 * a; }
                                else { o1[4 * gq] = o1[4 * gq] * c + s0 * a; o1[4 * gq + 1] = o1[4 * gq + 1] * c + s1 * a; o1[4 * gq + 2] = o1[4 * gq + 2] * c + s2 * a; o1[4 * gq + 3] = o1[4 * gq + 3] * c + s3 * a; } }
                    }
                    if (br < 2) {
                        if (hi == 0) ML[ql] = (f32x2){m, l};
#pragma unroll
                        for (int dt = 0; dt < 2; ++dt)
#pragma unroll
                            for (int gq = 0; gq < 4; ++gq) { u32x2 w;
                                if (dt == 0) { w.x = pk2(o0[4 * gq], o0[4 * gq + 1]); w.y = pk2(o0[4 * gq + 2], o0[4 * gq + 3]); } else { w.x = pk2(o1[4 * gq], o1[4 * gq + 1]); w.y = pk2(o1[4 * gq + 2], o1[4 * gq + 3]); }
                                *(LAS u32x2*)(orow + (32 * dt + 8 * gq) * 2) = w; }
                    } else {
                        const int row = b * SEQ + t;
                        finalize_store(o0, o1, l, OB + (size_t)row * D + 512 + 64 * hb, SSQ + (size_t)row * 16 + 8 + hb, hi);
                    }
                }
                __syncthreads();
            }
        }
#endif
#if !defined(NO_SAMPLE)
        {
            const int c = lane & 15, g4 = lane >> 4;
            for (int item = gw; item < DB * DS * 8; item += NGW) {
                const int hq = item & 7, ii = (item >> 3) & 3, b = item >> 5, hkv = hq >> 2, row = MP + b * DS + ii;
                const f32x4 q4 = load_q4(QKV, row, 64 * hq, c);
                SSt st; st.m = -INFINITY; st.l = 0.f; st.o = (f32x4){0.f, 0.f, 0.f, 0.f};
                const int ncache = WA - 1 - ii;
#pragma unroll 1
                for (int it0 = 0; it0 < WA / 4; it0 += 4) {
                    f32x4 k4[4], v4[4];
#pragma unroll
                    for (int u = 0; u < 4; ++u) { const int n = 4 * (it0 + u) + g4;
                        const bool isnew = n >= ncache;
                        const size_t o = (((size_t)b * WA + (isnew ? WA - DS + (n - ncache) : ii + 1 + n)) * 2 + hkv) * 64 + 4 * c;
                        const float* kp = (isnew ? out + O_SAK : cak) + o; const float* vp = (isnew ? out + O_SAV : cav) + o;
                        k4[u] = *(const f32x4*)kp; v4[u] = *(const f32x4*)vp; }
#pragma unroll
                    for (int u = 0; u < 4; ++u) s_step(st, q4, k4[u], v4[u], true);
                }
                s_merge(st);
                { const float sk = sinks[hq] * LOG2E, mn = fmaxf(st.m, sk), a = ex2(st.m - mn); st.l = st.l * a + ex2(sk - mn); st.o = st.o * a; st.m = mn; }
                s_store(st, OB + (size_t)row * D + 64 * hq, SSQ + (size_t)row * 16 + hq, lane);
            }
            for (int item = gw; item < DB * DS * 8; item += NGW) {
                const int hb = item & 7, ii = (item >> 3) & 3, b = item >> 5, row = MP + b * DS + ii;
                const f32x4 q4 = load_q4(QKV, row, 768 + 64 * hb, c);
                SSt st; st.m = -INFINITY; st.l = 0.f; st.o = (f32x4){0.f, 0.f, 0.f, 0.f};
#pragma unroll 1
                for (int it0 = 0; it0 < 100; it0 += 4) {
                    f32x4 k4[4], v4[4]; bool valid[4];
#pragma unroll
                    for (int u = 0; u < 4; ++u) { int n = 4 * (it0 + u) + g4; valid[u] = n < 387; n = valid[u] ? n : 386;
                        const int br = n < 129 ? 0 : n < 258 ? 1 : 2, j = n - 129 * br, idx = WB + ii - (j << (2 * br));
                        const bool isnew = idx >= WB;
                        const size_t o = (((size_t)b * WB + (isnew ? idx - DS : idx)) * 8 + hb) * 64 + 4 * c;
                        const float* kp = (isnew ? out + O_SBK : cbk) + o; const float* vp = (isnew ? out + O_SBV : cbv) + o;
                        k4[u] = *(const f32x4*)kp; v4[u] = *(const f32x4*)vp; }
#pragma unroll
                    for (int u = 0; u < 4; ++u) s_step(st, q4, k4[u], v4[u], valid[u]);
                }
                s_merge(st);
                s_store(st, OB + (size_t)row * D + 512 + 64 * hb, SSQ + (size_t)row * 16 + 8 + hb, lane);
            }
        }
#endif
    }
#endif
    xcd_barrier(bar);

#if (PH_MASK >> 4) & 1
    {
        pg8::Gemm g{OB, Wo_t, MT, D, D}; pg8::StaticOrder S; S.init(MT, D, G, bx);
        LAS pg8::f32x2v* tab = (LAS pg8::f32x2v*)(lds + TAB_OFF);
        for (int ui = 0; ui < 2; ++ui) { pg8::Unit u;
            if (S.next(ui, u) && tid < 256) { const int row = u.pm * 256 + tid; const f32x4* sp = (const f32x4*)(SSQ + (size_t)row * 16);
                const f32x4 a0 = sp[0], a1 = sp[1], b0 = sp[2], b1 = sp[3];
                const float sa = ((a0.x + a0.y) + (a0.z + a0.w)) + ((a1.x + a1.y) + (a1.z + a1.w)), sb = ((b0.x + b0.y) + (b0.z + b0.w)) + ((b1.x + b1.y) + (b1.z + b1.w));
                const float ra = 1.f / sqrtf(sa * (1.f / 512.f) + EPS), rb = 1.f / sqrtf(sb * (1.f / 512.f) + EPS);
                tab[ui * 256 + tid] = (pg8::f32x2v){ra / rb, rb}; } }
        __syncthreads();
        pg8::EpiOut E{xp, xs, MOD, X1, tab};
        pg8::gemm_phase<pg8::EpiOut, pg8::StaticOrder, true, true>(lds + RING_OFF, g, S, E);
    }
#endif
    xcd_barrier(bar);

#if (PH_MASK >> 5) & 1
    for (int row = gw; row < MT; row += NGW) { const float* mr = MOD + (size_t)mod_row(row) * NMOD;
        normmod_row(X1 + (size_t)row * D, g_ffn, mr + 3072, mr + 4096, XN + (size_t)row * D, lane); }
#endif
    xcd_barrier(bar);

#if (PH_MASK >> 6) & 1
    {
        pg8::Gemm g{XN, Wgu_t, MT, 2 * FF, D}; pg8::StaticOrder S; S.init(MT, 2 * FF, G, bx);
        pg8::EpiGU E{HM};
        pg8::gemm_phase<pg8::EpiGU, pg8::StaticOrder, true, true>(lds + RING_OFF, g, S, E);
    }
#endif
    xcd_barrier(bar);

#if (PH_MASK >> 7) & 1
    {
        pg8::Gemm g{HM, Wd_t, MT, D, FF}; pg8::StaticOrder S; S.init(MT, D, G, bx);
        pg8::EpiDown E{X1, MOD, out + O_Y};
        pg8::gemm_phase<pg8::EpiDown, pg8::StaticOrder, true, true>(lds + RING_OFF, g, S, E);
    }
#endif
    xcd_barrier(bar);

#if (PH_MASK >> 8) & 1
    for (int row = gw; row < MT; row += NGW) final_row(out + O_Y + (size_t)row * D, g_final, lane);
#endif
}

extern "C" void kernel_launch(void* const* d_in, const int* in_sizes, int n_in, void* d_out, int out_size, void* d_ws, size_t ws_size, hipStream_t stream) {
    static int grid = 0;
    if (grid == 0) {
        if (n_in != 21 || (size_t)out_size != O_END || ws_size < WS_END) { fprintf(stderr, "kernel_launch: unexpected shapes (n_in %d, out %d, ws %zu); nothing launched\n", n_in, out_size, ws_size); grid = -1; return; }
        if (hipFuncSetAttribute((const void*)mk_fwd, hipFuncAttributeMaxDynamicSharedMemorySize, LDS_BYTES) != hipSuccess) { fprintf(stderr, "kernel_launch: hipFuncSetAttribute failed\n"); grid = -1; return; }
        int per_cu = 0;
        if (hipOccupancyMaxActiveBlocksPerMultiprocessor(&per_cu, (const void*)mk_fwd, NTHREADS, LDS_BYTES) != hipSuccess || per_cu < 1) fprintf(stderr, "kernel_launch: note: occupancy query reports %d workgroups per CU\n", per_cu);
        (void)hipGetLastError();
        grid = 256;
    }
    if (grid < 0) return;
    (void)in_sizes;
    if (hipMemsetAsync((char*)d_ws + WS_CTL, 0, CTL_ZERO_BYTES, stream) != hipSuccess) { fprintf(stderr, "kernel_launch: hipMemsetAsync failed\n"); return; }
    Args a{};
    for (int i = 0; i < 21; ++i) a.in[i] = (const float*)d_in[i];
    a.out = (float*)d_out; a.ws = (unsigned char*)d_ws;
    hipLaunchKernelGGL(mk_fwd, dim3(grid), dim3(NTHREADS), LDS_BYTES, stream, a);
    const hipError_t le = hipPeekAtLastError();
    if (le != hipSuccess) fprintf(stderr, "kernel_launch: launch failed: %s\n", hipGetErrorName(le));
}
```

```cpp
#include <hip/hip_runtime.h>
#include <cstdio>
#include <cstdint>

constexpr int D = 1024, SEQ = 8192, NB = 2, DB = 128, DS = 4;
constexpr int MP = NB * SEQ, MS = DB * DS, MT = MP + MS;
constexpr int INC = 2304, FF = 2816, NMOD = 6144, NMB = NB + DB;
constexpr int WA = 128, WB = 2048, NPOS = SEQ + DS;
constexpr float EPS = 1e-6f;
#ifndef NCOPY
#define NCOPY 56
#endif
constexpr int NGRID = 256, NCOMP = NGRID - NCOPY;
#define XB_NPART ((unsigned)NCOMP)
constexpr float C2 = 0.125f * 1.4426950408889634f;
constexpr float LOG2E = 1.4426950408889634f;
constexpr size_t O_Y = 0;
constexpr size_t O_PAK = (size_t)MT * D;
constexpr size_t O_PAV = O_PAK + (size_t)NB * WA * 128;
constexpr size_t O_PBK = O_PAV + (size_t)NB * WA * 128;
constexpr size_t O_PBV = O_PBK + (size_t)NB * WB * 512;
constexpr size_t O_SAK = O_PBV + (size_t)NB * WB * 512;
constexpr size_t O_SAV = O_SAK + (size_t)DB * WA * 128;
constexpr size_t O_SBK = O_SAV + (size_t)DB * WA * 128;
constexpr size_t O_SBV = O_SBK + (size_t)DB * WB * 512;
constexpr size_t O_END = O_SBV + (size_t)DB * WB * 512;
static_assert(O_END == 294191104ull, "output map");

__device__ __forceinline__ int mod_row(int r) { return r < MP ? (r >> 13) : NB + ((r - MP) >> 2); }
__device__ __forceinline__ int pos_of(int r) { return r < MP ? (r & (SEQ - 1)) : SEQ + ((r - MP) & 3); }

namespace pg8 {
#define PG8_LAS __attribute__((address_space(3)))
typedef unsigned short bf16_t;
typedef short bf16x8 __attribute__((ext_vector_type(8)));
typedef float f32x4 __attribute__((ext_vector_type(4)));
typedef unsigned u32x4 __attribute__((ext_vector_type(4)));
constexpr int BM = 256, BK = 64, HALF = 128, HTB = HALF * BK * 2  , STAGE_BYTES = 8 * HTB, NXCD = 8, WGM = 8;

__host__ __device__ __forceinline__ int lds_byte(int r, int c) { const int st = (r >> 4) * 2 + (c >> 5), rr = r & 15, cc = c & 31, ob = rr * 64 + cc * 2; return st * 1024 + (ob ^ (((ob >> 9) & 1) << 5)); }
__host__ __device__ __forceinline__ void stage_rc(int b, int& R, int& C) { const int st = b / 1024, sb = b % 1024, swz = sb ^ (((sb >> 9) & 1) << 5); R = (st >> 1) * 16 + swz / 64; C = (st & 1) * 32 + (swz % 64) / 2; }
__host__ __device__ __forceinline__ int perm32(int rho) { const int n = rho >> 4, i = rho & 15; return 8 * (i >> 2) + 4 * n + (i & 3); }

struct Unit { int pm, pn; };
struct Gemm { const bf16_t* A; const bf16_t* Bt; int M, N, K; };

struct StaticOrder {
    int nM, nN, nwg, G, c;
    __host__ __device__ void init(int M, int N, int G_, int c_) { nM = M / BM; nN = N / BM; nwg = nM * nN; G = G_; c = c_; }
    __host__ __device__ bool next(int i, Unit& u) const {
        const long L = (long)i * G + c; if (L >= nwg) return false;
        int wgid = (int)L; { const int q = nwg / NXCD, r = nwg % NXCD, xcd = wgid % NXCD, off = wgid / NXCD; wgid = (xcd < r ? xcd * (q + 1) : r * (q + 1) + (xcd - r) * q) + off; }
        const int nig = WGM * nN, gid = wgid / nig, fm = gid * WGM, gsz = (nM - fm) < WGM ? (nM - fm) : WGM;
        u.pm = fm + ((wgid % nig) % gsz); u.pn = (wgid % nig) / gsz; return true;
    }
    __device__ __forceinline__ void a_ready(const Unit&) const {}
    __device__ __forceinline__ void done(const Unit&) const {}
};


typedef float f32x2v __attribute__((ext_vector_type(2)));
typedef unsigned u32x2v __attribute__((ext_vector_type(2)));
__device__ __forceinline__ unsigned cvt_pk_bf16(float lo, float hi) { unsigned r; asm volatile("v_cvt_pk_bf16_f32 %0, %1, %2" : "=v"(r) : "v"(lo), "v"(hi)); return r; }

struct EpiQKV {
    static constexpr bool PERM = true, AFTER_DRAIN = false; static constexpr int MID_T = 0;
    bf16_t* QKV; const float* COS; const float* SIN; float* out;
    __device__ __forceinline__ void operator()(const f32x4 (&acc)[2][2][4][2], const Unit& u, int ui, int wr, int wc, int fr, int fq) const {
        (void)ui;
        const int rowt = u.pm * BM + wr * 64 + fr;
        const bool samp = u.pm >= MP / BM;
        const int i0 = 16 * (wc & 1) + 4 * fq;
#pragma unroll
        for (int bj = 0; bj < 2; ++bj) {
            const int pc = u.pn * BM + bj * HALF + wc * 32 + 8 * fq;
            const int h64 = u.pn * 4 + bj * 2 + (wc >> 1);
            const bool isq = h64 < 8 || (h64 >= 12 && h64 < 20);
            const bool isk = (h64 >= 8 && h64 < 10) || (h64 >= 20 && h64 < 28);
            const bool isA = h64 >= 8 && h64 < 12, isB = h64 >= 20;
            const bool isv = !isq && !isk;
            const int hk = isA ? (h64 & 1) : ((h64 - 20) & 7);
            float* cbase = out;
            if (isA) cbase = out + (samp ? (isk ? O_SAK : O_SAV) : (isk ? O_PAK : O_PAV));
            if (isB) cbase = out + (samp ? (isk ? O_SBK : O_SBV) : (isk ? O_PBK : O_PBV));
            const int off1 = isk ? i0 : (pc & 63), off2 = isk ? 32 + i0 : (pc & 63) + 4;
#pragma unroll
            for (int ai = 0; ai < 2; ++ai)
#pragma unroll
                for (int m = 0; m < 4; ++m) {
                    const int row = rowt + ai * HALF + m * 16;
                    f32x4 v0 = acc[ai][bj][m][0], v1 = acc[ai][bj][m][1];
                    if (!isv) {
                        const int pos = samp ? SEQ + (row & 3) : (row & (SEQ - 1));
                        const f32x4 cs = *(const f32x4*)(COS + pos * 32 + i0), sn = *(const f32x4*)(SIN + pos * 32 + i0);
                        const f32x4 a = v0 * cs - v1 * sn, b = v1 * cs + v0 * sn;
                        v0 = a; v1 = b;
                        if (isq) { v0 = v0 * C2; v1 = v1 * C2; }
                    }
                    u32x4 w; w.x = cvt_pk_bf16(v0[0], v0[1]); w.y = cvt_pk_bf16(v0[2], v0[3]); w.z = cvt_pk_bf16(v1[0], v1[1]); w.w = cvt_pk_bf16(v1[2], v1[3]);
                    *(u32x4*)(QKV + (size_t)row * INC + pc) = w;
                    if (isA || isB) {
                        long slot = -1;
                        if (samp) { const int bs = (row - MP) >> 2, ii = row & 3; slot = isA ? (long)(bs * WA + WA - DS + ii) * 2 : (long)(bs * WB + WB - DS + ii) * 8; }
                        else { const int b = u.pm >> 5, t = row & (SEQ - 1);
                            if (isA) { if (t >= SEQ - WA) slot = (long)(b * WA + t - (SEQ - WA)) * 2; }
                            else { if (t >= SEQ - WB) slot = (long)(b * WB + t - (SEQ - WB)) * 8; } }
                        if (slot >= 0) { float* dst = cbase + (slot + hk) * 64; __builtin_nontemporal_store(v0, (f32x4*)(dst + off1)); __builtin_nontemporal_store(v1, (f32x4*)(dst + off2)); }
                    }
                }
        }
    }
};

struct EpiOut {
    static constexpr bool PERM = false, AFTER_DRAIN = false; static constexpr int MID_T = 8;
    const float* mod; bf16_t* X1; const PG8_LAS f32x2v* tab; unsigned* pcnt;
    __device__ __forceinline__ void mid(f32x4 (&acc)[2][2][4][2], int ui, int wr, int fr) const {
#pragma unroll
        for (int ai = 0; ai < 2; ++ai)
#pragma unroll
            for (int m = 0; m < 4; ++m) { const float ratio = tab[(ui & 1) * 256 + ai * HALF + wr * 64 + m * 16 + fr].x;
#pragma unroll
                for (int bj = 0; bj < 2; ++bj)
#pragma unroll
                    for (int n = 0; n < 2; ++n) acc[ai][bj][m][n] = acc[ai][bj][m][n] * ratio; }
    }
    __device__ __forceinline__ void operator()(const f32x4 (&acc)[2][2][4][2], const Unit& u, int ui, int wr, int wc, int fr, int fq) const {
        const int col0 = u.pn * BM + wc * 32 + 4 * fq;
#pragma unroll
        for (int ai = 0; ai < 2; ++ai)
#pragma unroll
            for (int m = 0; m < 4; ++m) { const int rl = ai * HALF + wr * 64 + m * 16 + fr, row = u.pm * BM + rl; const float rb = tab[(ui & 1) * 256 + rl].y;
                const float* grow = mod + (size_t)mod_row(row) * NMOD + 2048;
#pragma unroll
                for (int bj = 0; bj < 2; ++bj)
#pragma unroll
                    for (int n = 0; n < 2; ++n) { const int col = col0 + bj * HALF + n * 16; const f32x4 g4 = *(const f32x4*)(grow + col);
                        const f32x4 o = g4 * (acc[ai][bj][m][n] * rb); u32x2v w; w.x = cvt_pk_bf16(o[0], o[1]); w.y = cvt_pk_bf16(o[2], o[3]);
                        __hip_atomic_store((__attribute__((address_space(1))) unsigned long long*)(X1 + (size_t)row * D + col), ((unsigned long long)w.y << 32) | w.x, __ATOMIC_RELAXED, __HIP_MEMORY_SCOPE_AGENT); } }
        asm volatile("s_waitcnt vmcnt(0)" ::: "memory");
        if ((threadIdx.x & 63) == 0) (void)__hip_atomic_fetch_add(pcnt + 64 * u.pm, 1u, __ATOMIC_RELAXED, __HIP_MEMORY_SCOPE_AGENT);
    }
};

struct EpiGU {
    static constexpr bool PERM = true, AFTER_DRAIN = false; static constexpr int MID_T = 0;
    bf16_t* HM;
    __device__ __forceinline__ float silu_mul(float g, float u) const { return g * u * __builtin_amdgcn_rcpf(1.0f + __builtin_amdgcn_exp2f(-LOG2E * g)); }
    __device__ __forceinline__ void operator()(const f32x4 (&acc)[2][2][4][2], const Unit& u, int ui, int wr, int wc, int fr, int fq) const {
        (void)ui;
        const int row0 = u.pm * BM + wr * 64 + fr, col = u.pn * HALF + wc * 32 + 8 * fq;
#pragma unroll
        for (int ai = 0; ai < 2; ++ai)
#pragma unroll
            for (int m = 0; m < 4; ++m) { const f32x4 g0 = acc[ai][0][m][0], g1 = acc[ai][0][m][1], u0 = acc[ai][1][m][0], u1 = acc[ai][1][m][1];
                u32x4 w; w.x = cvt_pk_bf16(silu_mul(g0[0], u0[0]), silu_mul(g0[1], u0[1])); w.y = cvt_pk_bf16(silu_mul(g0[2], u0[2]), silu_mul(g0[3], u0[3]));
                w.z = cvt_pk_bf16(silu_mul(g1[0], u1[0]), silu_mul(g1[1], u1[1])); w.w = cvt_pk_bf16(silu_mul(g1[2], u1[2]), silu_mul(g1[3], u1[3]));
                *(u32x4*)(HM + (size_t)(row0 + ai * HALF + m * 16) * FF + col) = w; }
    }
};

struct EpiDown {
    static constexpr bool PERM = false, AFTER_DRAIN = false; static constexpr int MID_T = 0;
    const bf16_t* X1; const float* mod; bf16_t* X2; unsigned* pcnt;
    __device__ __forceinline__ void operator()(const f32x4 (&acc)[2][2][4][2], const Unit& u, int ui, int wr, int wc, int fr, int fq) const {
        (void)ui;
        const int col0 = u.pn * BM + wc * 32 + 4 * fq;
#pragma unroll
        for (int ai = 0; ai < 2; ++ai)
#pragma unroll
            for (int m = 0; m < 4; ++m) { const int row = u.pm * BM + ai * HALF + wr * 64 + m * 16 + fr;
                const bf16_t* xrow = X1 + (size_t)row * D; const float* grow = mod + (size_t)mod_row(row) * NMOD + 5120;
#pragma unroll
                for (int bj = 0; bj < 2; ++bj)
#pragma unroll
                    for (int n = 0; n < 2; ++n) { const int col = col0 + bj * HALF + n * 16; const u32x2v xw = *(const u32x2v*)(xrow + col); const f32x4 g4 = *(const f32x4*)(grow + col);
                        const f32x4 x4 = (f32x4){__uint_as_float(xw.x << 16), __uint_as_float(xw.x & 0xffff0000u), __uint_as_float(xw.y << 16), __uint_as_float(xw.y & 0xffff0000u)};
                        const f32x4 o = x4 + g4 * acc[ai][bj][m][n]; u32x2v w; w.x = cvt_pk_bf16(o[0], o[1]); w.y = cvt_pk_bf16(o[2], o[3]);
                        __hip_atomic_store((__attribute__((address_space(1))) unsigned long long*)(X2 + (size_t)row * D + col), ((unsigned long long)w.y << 32) | w.x, __ATOMIC_RELAXED, __HIP_MEMORY_SCOPE_AGENT); } }
        asm volatile("s_waitcnt vmcnt(0)" ::: "memory");
        if ((threadIdx.x & 63) == 0) (void)__hip_atomic_fetch_add(pcnt + 64 * u.pm, 1u, __ATOMIC_RELAXED, __HIP_MEMORY_SCOPE_AGENT);
    }
};

template <class Epi, class Sched, bool ALIGN_EPI = false, bool SP2 = false>
__device__ __forceinline__ void gemm_phase(PG8_LAS unsigned char* lds, const Gemm g, const Sched& S, const Epi& E) {
    int tid_ = threadIdx.x; asm volatile("" : "+v"(tid_));
    const int tid = tid_, wid = __builtin_amdgcn_readfirstlane(tid >> 6), lane = tid & 63, wr = wid >> 2, wc = wid & 3, fr = lane & 15, fq = lane >> 4;
    const int K = g.K, nt = K / BK;
    unsigned voffA[2], voffB[2];
#pragma unroll
    for (int i = 0; i < 2; ++i) { int R, C; stage_rc(tid * 16 + i * 8192, R, C); const int Rb = Epi::PERM ? ((R & ~31) + perm32(R & 31)) : R;
        voffA[i] = (unsigned)(R * K + C) * 2u; voffB[i] = (unsigned)(Rb * K + C) * 2u; }
    const size_t kstep = (size_t)(BK * 2);
    const size_t hstep = (size_t)HALF * K * 2;
    const size_t tstep = 2 * hstep;
    const unsigned ldsw = (unsigned)wid * 1024u;
    const int aoff = lds_byte(wr * 64 + fr, fq * 8), boff = lds_byte(wc * 32 + fr, fq * 8);
    const unsigned pfz = (unsigned)__builtin_amdgcn_readfirstlane((int)((unsigned)(size_t)lds + 139264u + (unsigned)wid * 256u));
    const unsigned pfv = (unsigned)(((wid & 3) * 64 + lane) * K) * 2u;
    const bool pfB = wid >= 4;
#define PG8_PF(pa, pb) do { const char* p_ = (pfB ? (pb) : (pa)) + pfv; asm volatile("s_mov_b32 m0, %1\n\ts_nop 0\n\tglobal_load_lds_dword %0, off" :: "v"(p_), "s"(pfz) : "m0"); } while (0)
#define PG8_SA(b, h) (((b) * 2 + (h)) * HTB)
#define PG8_SB(b, h) ((4 + (b) * 2 + (h)) * HTB)
#define PG8_STAGE(bufoff, gbase, voff) do { _Pragma("unroll") for (int _i = 0; _i < 2; ++_i) \
        __builtin_amdgcn_global_load_lds((const unsigned*)((const char*)(gbase) + (voff)[_i]), (PG8_LAS unsigned*)(lds + (bufoff) + ldsw + _i * 8192), 16, 0, 0); } while (0)
#define PG8_LDA(dst, b, h) do { _Pragma("unroll") for (int m = 0; m < 4; ++m) _Pragma("unroll") for (int k = 0; k < 2; ++k) dst[m][k] = *(const PG8_LAS bf16x8*)(lds + PG8_SA(b, h) + aoff + m * 2048 + k * 1024); } while (0)
#define PG8_LDB(dst, b, h) do { _Pragma("unroll") for (int n = 0; n < 2; ++n) _Pragma("unroll") for (int k = 0; k < 2; ++k) dst[n][k] = *(const PG8_LAS bf16x8*)(lds + PG8_SB(b, h) + boff + n * 2048 + k * 1024); } while (0)
#define PG8_MMA(ai, bj, At, Bt) do { __builtin_amdgcn_s_setprio(1); _Pragma("unroll") for (int m = 0; m < 4; ++m) _Pragma("unroll") for (int n = 0; n < 2; ++n) _Pragma("unroll") for (int k = 0; k < 2; ++k) \
        acc[ai][bj][m][n] = __builtin_amdgcn_mfma_f32_16x16x32_bf16(Bt[n][k], At[m][k], acc[ai][bj][m][n], 0, 0, 0); __builtin_amdgcn_s_setprio(0); } while (0)
#define PG8_WAIT_V(n) asm volatile("s_waitcnt vmcnt(" #n ")" ::: "memory")
#define PG8_WAIT_L(n) asm volatile("s_waitcnt lgkmcnt(" #n ")" ::: "memory")
#define PG8_BAR __builtin_amdgcn_s_barrier()
#define PG8_SCHED __builtin_amdgcn_sched_barrier(0)
    Unit cur, nxt; int ui = 0;
    if (!S.next(0, cur)) return;
    f32x4 acc[2][2][4][2];
#pragma unroll
    for (int a = 0; a < 2; ++a)
#pragma unroll
        for (int b = 0; b < 2; ++b)
#pragma unroll
            for (int m = 0; m < 4; ++m)
#pragma unroll
                for (int n = 0; n < 2; ++n) acc[a][b][m][n] = (f32x4){0.f, 0.f, 0.f, 0.f};
    bf16x8 At[4][2], B0[2][2], B1[2][2];
    const char* cA = (const char*)g.A + (size_t)cur.pm * tstep; const char* cB = (const char*)g.Bt + (size_t)cur.pn * tstep;
    S.a_ready(cur);
    if constexpr (SP2) {
        PG8_STAGE(PG8_SB(0, 0), cB, voffB); PG8_STAGE(PG8_SB(0, 1), cB + hstep, voffB); PG8_STAGE(PG8_SA(0, 0), cA, voffA); PG8_STAGE(PG8_SA(0, 1), cA + hstep, voffA);
        if (wr == 1) PG8_BAR;
        PG8_WAIT_V(2); PG8_BAR;
        PG8_STAGE(PG8_SB(1, 0), cB + kstep, voffB); PG8_STAGE(PG8_SA(1, 0), cA + kstep, voffA); PG8_STAGE(PG8_SB(1, 1), cB + hstep + kstep, voffB);
        PG8_WAIT_V(6); PG8_BAR;
    } else {
        PG8_STAGE(PG8_SB(0, 0), cB, voffB); PG8_STAGE(PG8_SA(0, 0), cA, voffA); PG8_STAGE(PG8_SB(0, 1), cB + hstep, voffB); PG8_STAGE(PG8_SA(0, 1), cA + hstep, voffA);
        if (wr == 1) PG8_BAR;
        PG8_WAIT_V(4); PG8_BAR;
        PG8_STAGE(PG8_SB(1, 0), cB + kstep, voffB); PG8_STAGE(PG8_SA(1, 0), cA + kstep, voffA); PG8_STAGE(PG8_SB(1, 1), cB + hstep + kstep, voffB);
        PG8_WAIT_V(6); PG8_BAR;
    }
    for (;;) {
        const bool has_next = S.next(ui + 1, nxt);
        const char* nA = has_next ? (const char*)g.A + (size_t)nxt.pm * tstep : cA; const char* nB = has_next ? (const char*)g.Bt + (size_t)nxt.pn * tstep : cB;
        for (int t = 0; t < nt; t += 2) {
            if constexpr (Epi::MID_T > 0) { if (t == Epi::MID_T) E.mid(acc, ui, wr, fr); }
            const bool last = (t == nt - 2);
            const char* a1 = cA + (size_t)(t + 1) * kstep;
            const char* a2 = last ? nA : cA + (size_t)(t + 2) * kstep; const char* b2 = last ? nB : cB + (size_t)(t + 2) * kstep;
            const char* a3 = a2 + kstep; const char* b3 = b2 + kstep;
            const char* pa4 = (t + 4 < nt) ? cA + (size_t)(t + 4) * kstep : nA + (size_t)(t + 4 - nt) * kstep; const char* pb4 = (t + 4 < nt) ? cB + (size_t)(t + 4) * kstep : nB + (size_t)(t + 4 - nt) * kstep;
            if (last && has_next) S.a_ready(nxt);
            if constexpr (SP2) {
            PG8_LDB(B0, 0, 0); PG8_LDB(B1, 0, 1); PG8_SCHED; PG8_LDA(At, 0, 0); PG8_STAGE(PG8_SA(1, 1), a1 + hstep, voffA); PG8_PF(pa4, pb4);
            PG8_WAIT_V(9); PG8_WAIT_L(0); PG8_BAR; PG8_MMA(0, 0, At, B0); PG8_MMA(0, 1, At, B1); PG8_BAR; PG8_SCHED;
            PG8_LDA(At, 0, 1); PG8_STAGE(PG8_SB(0, 0), b2, voffB); PG8_STAGE(PG8_SB(0, 1), b2 + hstep, voffB); PG8_STAGE(PG8_SA(0, 0), a2, voffA);
            PG8_WAIT_V(9); PG8_WAIT_L(0); PG8_BAR; PG8_MMA(1, 0, At, B0); PG8_MMA(1, 1, At, B1); PG8_BAR; PG8_SCHED;
            PG8_LDB(B0, 1, 0); PG8_LDB(B1, 1, 1); PG8_SCHED; PG8_LDA(At, 1, 0); PG8_STAGE(PG8_SA(0, 1), a2 + hstep, voffA); PG8_PF(pa4 + kstep, pb4 + kstep);
            PG8_WAIT_V(9); PG8_WAIT_L(0); PG8_BAR; PG8_MMA(0, 0, At, B0); PG8_MMA(0, 1, At, B1); PG8_BAR; PG8_SCHED;
            PG8_LDA(At, 1, 1); PG8_STAGE(PG8_SB(1, 0), b3, voffB); PG8_STAGE(PG8_SB(1, 1), b3 + hstep, voffB); PG8_STAGE(PG8_SA(1, 0), a3, voffA);
            PG8_WAIT_V(9); PG8_WAIT_L(0); PG8_BAR; PG8_MMA(1, 0, At, B0); PG8_MMA(1, 1, At, B1); PG8_BAR; PG8_SCHED;
            } else {
            PG8_LDB(B0, 0, 0); PG8_SCHED; PG8_LDA(At, 0, 0); PG8_STAGE(PG8_SA(1, 1), a1 + hstep, voffA);
            PG8_WAIT_L(8); PG8_BAR; PG8_WAIT_L(0); PG8_MMA(0, 0, At, B0); PG8_BAR; PG8_SCHED;
            PG8_LDB(B1, 0, 1); PG8_STAGE(PG8_SB(0, 0), b2, voffB);
            PG8_BAR; PG8_WAIT_L(0); PG8_MMA(0, 1, At, B1); PG8_BAR;
            PG8_LDA(At, 0, 1); PG8_STAGE(PG8_SA(0, 0), a2, voffA);
            PG8_BAR; PG8_WAIT_L(0); PG8_MMA(1, 0, At, B0); PG8_BAR; PG8_SCHED;
            PG8_STAGE(PG8_SB(0, 1), b2 + hstep, voffB);
            PG8_WAIT_V(6); PG8_BAR; PG8_MMA(1, 1, At, B1); PG8_BAR;
            PG8_LDB(B0, 1, 0); PG8_SCHED; PG8_LDA(At, 1, 0); PG8_STAGE(PG8_SA(0, 1), a2 + hstep, voffA);
            PG8_WAIT_L(8); PG8_BAR; PG8_WAIT_L(0); PG8_MMA(0, 0, At, B0); PG8_BAR; PG8_SCHED;
            PG8_LDB(B1, 1, 1); PG8_STAGE(PG8_SB(1, 0), b3, voffB);
            PG8_BAR; PG8_WAIT_L(0); PG8_MMA(0, 1, At, B1); PG8_BAR;
            PG8_LDA(At, 1, 1); PG8_STAGE(PG8_SA(1, 0), a3, voffA);
            PG8_BAR; PG8_WAIT_L(0); PG8_MMA(1, 0, At, B0); PG8_BAR; PG8_SCHED;
            PG8_STAGE(PG8_SB(1, 1), b3 + hstep, voffB);
            PG8_WAIT_V(6); PG8_BAR; PG8_MMA(1, 1, At, B1); PG8_BAR;
            }
        }
        if constexpr (ALIGN_EPI) { if (wr == 0) PG8_BAR; }
        if constexpr (!Epi::AFTER_DRAIN) { E(acc, cur, ui, wr, wc, fr, fq); S.done(cur); }
        if (!has_next) break;
#pragma unroll
        for (int a = 0; a < 2; ++a)
#pragma unroll
            for (int b = 0; b < 2; ++b)
#pragma unroll
                for (int m = 0; m < 4; ++m)
#pragma unroll
                    for (int n = 0; n < 2; ++n) acc[a][b][m][n] = (f32x4){0.f, 0.f, 0.f, 0.f};
        cur = nxt; cA = nA; cB = nB; ++ui;
        if constexpr (ALIGN_EPI) { if (wr == 1) PG8_BAR; }
    }
    PG8_WAIT_V(0);
    if constexpr (!ALIGN_EPI) { if (wr == 0) PG8_BAR; }
    PG8_BAR;
    if constexpr (Epi::AFTER_DRAIN) { E.fused(acc, cur, wr, wc, fr, fq, lds, wid, lane); S.done(cur); }
#undef PG8_PF
#undef PG8_SA
#undef PG8_SB
#undef PG8_STAGE
#undef PG8_LDA
#undef PG8_LDB
#undef PG8_MMA
#undef PG8_WAIT_V
#undef PG8_WAIT_L
#undef PG8_BAR
#undef PG8_SCHED
}
}
#define GAS __attribute__((address_space(1)))
#define LAS __attribute__((address_space(3)))
typedef unsigned short bf16;
typedef unsigned v4u __attribute__((ext_vector_type(4)));
typedef float f32x4 __attribute__((ext_vector_type(4)));
typedef short bf16x8 __attribute__((ext_vector_type(8)));
typedef GAS unsigned gu32;
typedef GAS unsigned long long gu64;
#define RLX_AGENT __ATOMIC_RELAXED, __HIP_MEMORY_SCOPE_AGENT
#define LDS_WAIT() asm volatile("s_waitcnt lgkmcnt(0)" ::: "memory")
#define VM_WAIT() asm volatile("s_waitcnt vmcnt(0)" ::: "memory")
__device__ __forceinline__ unsigned long long rt() { return __builtin_amdgcn_s_memrealtime(); }
__device__ __forceinline__ unsigned f2bf(float f) { unsigned u = __builtin_bit_cast(unsigned, f); return (u + 0x7fffu + ((u >> 16) & 1u)) >> 16; }
__device__ __forceinline__ unsigned pk2(float lo, float hi) { return f2bf(lo) | (f2bf(hi) << 16); }

#define XB_TMO      128
#define XB_XCNT(j)  (256  + 64 * (j))
#define XB_XSUB(j)  (1280 + 64 * (j))
#define XB_XGEN(j)  (2304 + 64 * (j))
#define XB_TOP      3328
#define XB_TOPGEN   3392
#define XCD_BAR_WORDS 3456
#define XB_SPIN_CAP (1u << 18)

__device__ __forceinline__ unsigned xb_ld(unsigned* p)              { return __hip_atomic_load(p, __ATOMIC_RELAXED, __HIP_MEMORY_SCOPE_AGENT); }
__device__ __forceinline__ unsigned xb_add(unsigned* p, unsigned v) { return __hip_atomic_fetch_add(p, v, __ATOMIC_RELAXED, __HIP_MEMORY_SCOPE_AGENT); }
__device__ __forceinline__ unsigned xb_xcc_id() { return (unsigned)__builtin_amdgcn_s_getreg((3 << 11) | 20) & 0xFu; }
#define XB_SPIN(cond, bar) do { unsigned _sp = 0; while (cond) { __builtin_amdgcn_s_sleep(1); \
    if ((++_sp & 255u) == 0u) { if (xb_ld(&(bar)[XB_TMO])) break; if (_sp > XB_SPIN_CAP) { atomicAdd(&(bar)[XB_TMO], 1u); break; } } } } while (0)

struct XcdBarrier {
    unsigned* bar; unsigned x;
    volatile LAS unsigned* st;
};

__device__ __forceinline__ XcdBarrier xcd_barrier_post(unsigned* bar, volatile LAS unsigned* st) {
    XcdBarrier b; b.bar = bar; b.x = xb_xcc_id(); b.st = st;
    if (threadIdx.x == 0) (void)xb_add(&bar[XB_XCNT(b.x)], 1u);
    return b;
}
__device__ __forceinline__ void xcd_barrier_complete(unsigned* bar, unsigned x, unsigned& nloc, unsigned& nx) {
    const unsigned G = XB_NPART;
    unsigned sum, cnt, mine, sp = 0u;
    for (;;) {
        sum = 0u; cnt = 0u; mine = 0u;
#pragma unroll
        for (unsigned j = 0; j < 16; ++j) { const unsigned c = xb_ld(&bar[XB_XCNT(j)]); sum += c; cnt += (c > 0u) ? 1u : 0u; mine = (j == x) ? c : mine; }
        if (sum == G) break;
        __builtin_amdgcn_s_sleep(1);
        if ((++sp & 255u) == 0u) { if (xb_ld(&bar[XB_TMO])) break; if (sp > XB_SPIN_CAP) { atomicAdd(&bar[XB_TMO], 1u); break; } }
    }
    nloc = mine > 0u ? mine : 1u; nx = cnt > 0u ? cnt : 1u;
}

__device__ __forceinline__ void xcd_barrier(const XcdBarrier& b) {
    asm volatile("s_waitcnt vmcnt(0)" ::: "memory");
    __syncthreads();
    if (threadIdx.x == 0) {
        unsigned* bar = b.bar;
        __builtin_amdgcn_s_waitcnt(0);
        unsigned nloc = b.st[0], nx = b.st[1];
        if (nloc == 0u) { xcd_barrier_complete(bar, b.x, nloc, nx); b.st[0] = nloc; b.st[1] = nx; }
        const unsigned old = xb_add(&bar[XB_XSUB(b.x)], 1u);
        const unsigned gen = old / nloc;
        if (old + 1u == (gen + 1u) * nloc) {
            __builtin_amdgcn_fence(__ATOMIC_RELEASE, "agent");
            asm volatile("s_waitcnt vmcnt(0)" ::: "memory");
            const unsigned og = xb_add(&bar[XB_TOP], 1u);
            const unsigned tg = og / nx;
            if (og + 1u == (tg + 1u) * nx) xb_add(&bar[XB_TOPGEN], 1u);
            else XB_SPIN(xb_ld(&bar[XB_TOPGEN]) == tg, bar);
            __builtin_amdgcn_fence(__ATOMIC_ACQUIRE, "agent");
            xb_add(&bar[XB_XGEN(b.x)], 1u);
            asm volatile("s_waitcnt vmcnt(0)" ::: "memory");
        } else {
            XB_SPIN(xb_ld(&bar[XB_XGEN(b.x)]) == gen, bar);
            __builtin_amdgcn_fence(__ATOMIC_ACQUIRE, "agent");
            asm volatile("s_waitcnt vmcnt(0)" ::: "memory");
        }
    }
    __syncthreads();
}


constexpr size_t MiB = 1u << 20;
constexpr size_t WS_CTL = 0, CTL_ZERO_BYTES = 1 * MiB;
constexpr size_t WS_MOD = 1 * MiB;
constexpr size_t WS_COS = 5 * MiB, WS_SIN = 7 * MiB;
constexpr size_t WS_SSQ = 9 * MiB;
constexpr size_t WS_WIN = 12 * MiB, WS_WO = 17 * MiB, WS_WGU = 20 * MiB, WS_WD = 32 * MiB;
constexpr size_t WS_XN = 40 * MiB;
constexpr size_t WS_QKV = 76 * MiB;
constexpr size_t WS_OB = 152 * MiB;
constexpr size_t WS_X1 = 186 * MiB;
constexpr size_t WS_HM = 256 * MiB;
constexpr size_t WS_X2 = 348 * MiB;
constexpr size_t WS_END = 382 * MiB;
static_assert(WS_MOD + (size_t)NMB * NMOD * 4 <= WS_COS && WS_COS + (size_t)NPOS * 32 * 4 <= WS_SIN && WS_SIN + (size_t)NPOS * 32 * 4 <= WS_SSQ && WS_SSQ + (size_t)MT * 16 * 4 <= WS_WIN, "ws map 1");
static_assert(WS_WIN + (size_t)INC * D * 2 <= WS_WO && WS_WO + (size_t)D * D * 2 <= WS_WGU && WS_WGU + (size_t)2 * FF * D * 2 <= WS_WD && WS_WD + (size_t)D * FF * 2 <= WS_XN, "ws map 2");
static_assert(WS_XN + (size_t)MT * D * 2 <= WS_QKV && WS_QKV + (size_t)MT * INC * 2 <= WS_OB && WS_OB + (size_t)MT * D * 2 <= WS_X1 && WS_X1 + (size_t)MT * D * 4 <= WS_HM && WS_HM + (size_t)MT * FF * 2 <= WS_X2 && WS_X2 + (size_t)MT * D * 2 <= WS_END, "ws map 3");
constexpr int CW_TMO = 0, CW_COPY_HEAD = 64, CW_ATT_HEAD = 128, CW_PAUSE = 192, CW_SETUP = 256, CW_P5_HEAD = 320, CW_P8_HEAD = 384, CW_ATTQ = 1024, CW_BAR = 4096, CW_PANEL4 = 8192, CW_PANEL7 = 16384;

constexpr int RING_OFF = 0, RING_BYTES = 131072;
constexpr int LDSCTL_OFF = RING_BYTES, MISC_OFF = LDSCTL_OFF + 320, TAB_OFF = LDSCTL_OFF + 1024;
constexpr int LDS_BYTES = 147456;
static_assert(TAB_OFF + 4096 <= LDS_BYTES, "LDS map");
constexpr int NWAVES = 8, NTHREADS = NWAVES * 64;

typedef float f32x16 __attribute__((ext_vector_type(16)));
typedef short s16x4 __attribute__((ext_vector_type(4)));
typedef short v4i16_t __attribute__((ext_vector_type(4)));
typedef unsigned u32x2 __attribute__((ext_vector_type(2)));
typedef float f32x2 __attribute__((ext_vector_type(2)));

__device__ __forceinline__ float bf2f(unsigned h) { return __uint_as_float(h << 16); }
__device__ __forceinline__ unsigned cvtpk(float lo, float hi) { unsigned r; asm("v_cvt_pk_bf16_f32 %0, %1, %2" : "=v"(r) : "v"(lo), "v"(hi)); return r; }
__device__ __forceinline__ float wave_sum(float v) {
#pragma unroll
    for (int o = 1; o < 64; o <<= 1) v += __shfl_xor(v, o);
    return v;
}
__device__ __forceinline__ float ex2(float x) { return __builtin_amdgcn_exp2f(x); }
#define DPP_F(v, ctrl) __builtin_bit_cast(float, __builtin_amdgcn_update_dpp(0, __builtin_bit_cast(int, (v)), (ctrl), 0xf, 0xf, false))
__device__ __forceinline__ float sum16(float v) { v += DPP_F(v, 0xB1); v += DPP_F(v, 0x4E); v += DPP_F(v, 0x141); v += DPP_F(v, 0x140); return v; }
__device__ __forceinline__ void swap32(float& a, float& b) { asm volatile("s_nop 1\n\tv_permlane32_swap_b32 %0, %1\n\ts_nop 1" : "+v"(a), "+v"(b)); }
__device__ __forceinline__ float xmax32(float v) { float a = v, b = v; swap32(a, b); return fmaxf(a, b); }
__device__ __forceinline__ float xsum32(float v) { float a = v, b = v; swap32(a, b); return a + b; }

__device__ __forceinline__ void split8(const float (&v)[8], bf16x8& hi, bf16x8& lo) {
#pragma unroll
    for (int i = 0; i < 8; ++i) { const unsigned h = f2bf(v[i]); hi[i] = (short)h; lo[i] = (short)f2bf(v[i] - bf2f(h)); }
}
__device__ __forceinline__ float silu_f(float x) { return x / (1.0f + ex2(-LOG2E * x)); }
__device__ __forceinline__ void ada_block(LAS unsigned char* lds, int ct, const float* cp, const float* cs, const float* w_ada, const float* b_ada, float* mod, int tid, int wave, int lane) {
    const int n0 = 32 * ct, ln = lane & 31, hi = lane >> 5;
    f32x16 acc[5];
#pragma unroll
    for (int rt = 0; rt < 5; ++rt)
#pragma unroll
        for (int r = 0; r < 16; ++r) acc[rt][r] = 0.f;
#pragma unroll 1
    for (int ks = 0; ks < 8; ++ks) {
        const int kb = 128 * wave + 16 * ks + 8 * hi;
        float bv[8];
#pragma unroll
        for (int i = 0; i < 8; ++i) bv[i] = __builtin_nontemporal_load(w_ada + (size_t)(kb + i) * NMOD + n0 + ln);
        bf16x8 bh, bl; split8(bv, bh, bl);
#pragma unroll
        for (int rt = 0; rt < 5; ++rt) {
            const int row = 32 * rt + ln;
            float av[8];
            if (row < NMB) { const float* c = (row < NB ? cp + (size_t)row * D : cs + (size_t)(row - NB) * D) + kb;
                const f32x4 c0 = *(const f32x4*)c, c1 = *(const f32x4*)(c + 4);
                av[0] = silu_f(c0[0]); av[1] = silu_f(c0[1]); av[2] = silu_f(c0[2]); av[3] = silu_f(c0[3]); av[4] = silu_f(c1[0]); av[5] = silu_f(c1[1]); av[6] = silu_f(c1[2]); av[7] = silu_f(c1[3]);
            } else {
#pragma unroll
                for (int i = 0; i < 8; ++i) av[i] = 0.f;
            }
            bf16x8 ah, al; split8(av, ah, al);
            acc[rt] = __builtin_amdgcn_mfma_f32_32x32x16_bf16(ah, bh, acc[rt], 0, 0, 0);
            acc[rt] = __builtin_amdgcn_mfma_f32_32x32x16_bf16(ah, bl, acc[rt], 0, 0, 0);
            acc[rt] = __builtin_amdgcn_mfma_f32_32x32x16_bf16(al, bh, acc[rt], 0, 0, 0);
        }
    }
    LAS float* red = (LAS float*)lds;
#pragma unroll
    for (int rt = 0; rt < 5; ++rt) {
#pragma unroll
        for (int r = 0; r < 16; ++r) red[(wave * 16 + r) * 64 + lane] = acc[rt][r];
        __syncthreads();
#pragma unroll
        for (int x = 0; x < 2; ++x) { const int e = tid + 512 * x, r = e >> 6, l2 = e & 63; float s = 0.f;
#pragma unroll
            for (int w = 0; w < 8; ++w) s += red[(w * 16 + r) * 64 + l2];
            const int mrow = 32 * rt + (r & 3) + 8 * (r >> 2) + 4 * (l2 >> 5), col = n0 + (l2 & 31);
            if (mrow < NMB) mod[(size_t)mrow * NMOD + col] = s + b_ada[col]; }
        __syncthreads();
    }
}

template <class RowMap>
__device__ __forceinline__ void tr_load(float (&v)[32], const float* W, int N, const float* sc_a, const float* sc_b, int item, int lane) {
    const int nblk = N / 32, kb = item / nblk, nb = item % nblk, k0 = 64 * kb, n0 = 32 * nb;
#pragma unroll
    for (int i = 0; i < 32; ++i) { const int kk = 2 * i + (lane >> 5); v[i] = __builtin_nontemporal_load(W + (size_t)(k0 + kk) * N + n0 + (lane & 31));
        if (sc_a) { const int k = k0 + kk; v[i] *= (k < 512 ? sc_a[k] : sc_b[k - 512]); } }
}
template <class RowMap>
__device__ __forceinline__ void tr_store(const float (&v)[32], int K, int N, bf16* WT, RowMap rm, LAS float* scr, int item, int lane) {
    const int nblk = N / 32, kb = item / nblk, nb = item % nblk, k0 = 64 * kb, n0 = 32 * nb;
#pragma unroll
    for (int i = 0; i < 32; ++i) scr[(2 * i + (lane >> 5)) * 33 + (lane & 31)] = v[i];
    LDS_WAIT(); asm volatile("" ::: "memory");
    const int c = lane & 7;
#pragma unroll
    for (int j = 0; j < 4; ++j) { const int n = (lane >> 3) + 8 * j; const LAS float* s = scr + (8 * c) * 33 + n;
        v4u o; o.x = cvtpk(s[0 * 33], s[1 * 33]); o.y = cvtpk(s[2 * 33], s[3 * 33]); o.z = cvtpk(s[4 * 33], s[5 * 33]); o.w = cvtpk(s[6 * 33], s[7 * 33]);
        *(GAS v4u*)(WT + (size_t)rm(n0 + n) * K + k0 + 8 * c) = o; }
    LDS_WAIT(); asm volatile("" ::: "memory");
}
template <class RowMap>
__device__ __forceinline__ void transpose_matrix(const float* W, int K, int N, bf16* WT, RowMap rm, const float* sc_a, const float* sc_b, LAS float* scr, int first, int stride, int nitems, int lane) {
    for (int it = first; it < nitems; it += 2 * stride) {
        float va[32], vb[32]; const int it2 = it + stride; const bool two = it2 < nitems;
        tr_load<RowMap>(va, W, N, sc_a, sc_b, it, lane);
        if (two) tr_load<RowMap>(vb, W, N, sc_a, sc_b, it2, lane);
        tr_store<RowMap>(va, K, N, WT, rm, scr, it, lane);
        if (two) tr_store<RowMap>(vb, K, N, WT, rm, scr, it2, lane);
    }
}
struct RmIn { __device__ __forceinline__ int operator()(int n) const { const int h64 = n >> 6, e = n & 63; const bool rot = h64 < 10 || (h64 >= 12 && h64 < 28);
    return rot ? (n & ~63) + 8 * ((e & 31) >> 2) + (e & 3) + 4 * (e >> 5) : n; } };
struct RmId { __device__ __forceinline__ int operator()(int n) const { return n; } };
struct RmGate { __device__ __forceinline__ int operator()(int n) const { return 256 * (n >> 7) + (n & 127); } };
struct RmUp { __device__ __forceinline__ int operator()(int n) const { return 256 * (n >> 7) + 128 + (n & 127); } };

__device__ __forceinline__ void rope_entry(int e, float* COS, float* SIN) {
    const int pos = e >> 5, i = e & 31;
    double inv = 1.0; for (int k = 0; k < i; ++k) inv *= 0.74989420933245582730;
    const double rev = (double)pos * inv * 0.15915494309189533577;
    const double fr = rev - __builtin_rint(rev);
    const double qd = __builtin_rint(fr * 4.0);
    const double z = (fr - qd * 0.25) * 6.28318530717958647693, z2 = z * z;
    const double s = z * (1.0 + z2 * (-1.0 / 6 + z2 * (1.0 / 120 + z2 * (-1.0 / 5040 + z2 * (1.0 / 362880 + z2 * (-1.0 / 39916800 + z2 * (1.0 / 6227020800.0)))))));
    const double c = 1.0 + z2 * (-0.5 + z2 * (1.0 / 24 + z2 * (-1.0 / 720 + z2 * (1.0 / 40320 + z2 * (-1.0 / 3628800 + z2 * (1.0 / 479001600.0))))));
    const int q = ((int)qd) & 3;
    const double sn = q == 0 ? s : q == 1 ? c : q == 2 ? -s : -c;
    const double cs = q == 0 ? c : q == 1 ? -s : q == 2 ? -c : s;
    COS[e] = (float)cs; SIN[e] = (float)sn;
}

__device__ __forceinline__ void normmod_row(const float* xrow, const float* g, const float* sh, const float* sc, bf16* orow, int lane) {
    const GAS f32x4* xr = (const GAS f32x4*)xrow + lane;
    f32x4 v[4]; float s = 0.f;
#pragma unroll
    for (int j = 0; j < 4; ++j) { v[j] = __builtin_nontemporal_load(xr + 64 * j); s += (v[j].x * v[j].x + v[j].y * v[j].y) + (v[j].z * v[j].z + v[j].w * v[j].w); }
    const float rstd = 1.f / sqrtf(wave_sum(s) * (1.f / D) + EPS);
    GAS unsigned long long* o8 = (GAS unsigned long long*)orow + lane;
#pragma unroll
    for (int j = 0; j < 4; ++j) { const f32x4 gg = ((const GAS f32x4*)g)[lane + 64 * j], hh = ((const GAS f32x4*)sh)[lane + 64 * j], cc = ((const GAS f32x4*)sc)[lane + 64 * j];
        const f32x4 o = v[j] * rstd * gg * (cc + 1.0f) + hh;
        o8[64 * j] = (unsigned long long)cvtpk(o.x, o.y) | ((unsigned long long)cvtpk(o.z, o.w) << 32); }
}
__device__ __forceinline__ void normmod_row_bf16(const bf16* xrow, const float* g, const float* sh, const float* sc, bf16* orow, int lane) {
    const GAS u32x2* xr = (const GAS u32x2*)xrow + lane;
    f32x4 v[4]; float s = 0.f;
#pragma unroll
    for (int j = 0; j < 4; ++j) { const u32x2 w = xr[64 * j]; v[j] = (f32x4){bf2f(w.x & 0xffffu), bf2f(w.x >> 16), bf2f(w.y & 0xffffu), bf2f(w.y >> 16)};
        s += (v[j].x * v[j].x + v[j].y * v[j].y) + (v[j].z * v[j].z + v[j].w * v[j].w); }
    const float rstd = 1.f / sqrtf(wave_sum(s) * (1.f / D) + EPS);
    GAS unsigned long long* o8 = (GAS unsigned long long*)orow + lane;
#pragma unroll
    for (int j = 0; j < 4; ++j) { const f32x4 gg = ((const GAS f32x4*)g)[lane + 64 * j], hh = ((const GAS f32x4*)sh)[lane + 64 * j], cc = ((const GAS f32x4*)sc)[lane + 64 * j];
        const f32x4 o = v[j] * rstd * gg * (cc + 1.0f) + hh;
        o8[64 * j] = (unsigned long long)cvtpk(o.x, o.y) | ((unsigned long long)cvtpk(o.z, o.w) << 32); }
}
__device__ __forceinline__ void resid_normmod_row(const float* xrow, bf16* trow, const float* g, const float* sh, const float* sc, bf16* orow, int lane) {
    const GAS f32x4* xr = (const GAS f32x4*)xrow + lane; GAS u32x2* tr = (GAS u32x2*)trow + lane;
    f32x4 v[4]; float s = 0.f;
#pragma unroll
    for (int j = 0; j < 4; ++j) { const u32x2 w = tr[64 * j]; v[j] = __builtin_nontemporal_load(xr + 64 * j) + (f32x4){bf2f(w.x & 0xffffu), bf2f(w.x >> 16), bf2f(w.y & 0xffffu), bf2f(w.y >> 16)};
        s += (v[j].x * v[j].x + v[j].y * v[j].y) + (v[j].z * v[j].z + v[j].w * v[j].w);
        u32x2 o; o.x = cvtpk(v[j].x, v[j].y); o.y = cvtpk(v[j].z, v[j].w); tr[64 * j] = o; }
    const float rstd = 1.f / sqrtf(wave_sum(s) * (1.f / D) + EPS);
    GAS unsigned long long* o8 = (GAS unsigned long long*)orow + lane;
#pragma unroll
    for (int j = 0; j < 4; ++j) { const f32x4 gg = ((const GAS f32x4*)g)[lane + 64 * j], hh = ((const GAS f32x4*)sh)[lane + 64 * j], cc = ((const GAS f32x4*)sc)[lane + 64 * j];
        const f32x4 o = v[j] * rstd * gg * (cc + 1.0f) + hh;
        o8[64 * j] = (unsigned long long)cvtpk(o.x, o.y) | ((unsigned long long)cvtpk(o.z, o.w) << 32); }
}
__device__ __forceinline__ void final_row(const bf16* xrow, float* yrow, const float* g, int lane) {
    const GAS u32x2* xr = (const GAS u32x2*)xrow + lane;
    f32x4 v[4]; float s = 0.f;
#pragma unroll
    for (int j = 0; j < 4; ++j) { const u32x2 w = xr[64 * j]; v[j] = (f32x4){bf2f(w.x & 0xffffu), bf2f(w.x >> 16), bf2f(w.y & 0xffffu), bf2f(w.y >> 16)};
        s += (v[j].x * v[j].x + v[j].y * v[j].y) + (v[j].z * v[j].z + v[j].w * v[j].w); }
    const float rstd = 1.f / sqrtf(wave_sum(s) * (1.f / D) + EPS);
    GAS f32x4* yr = (GAS f32x4*)yrow + lane;
#pragma unroll
    for (int j = 0; j < 4; ++j) __builtin_nontemporal_store(v[j] * rstd * ((const GAS f32x4*)g)[lane + 64 * j], yr + 64 * j);
}

__device__ __forceinline__ s16x4 vtr(const LAS unsigned char* p) { return __builtin_bit_cast(s16x4, __builtin_amdgcn_ds_read_tr16_b64_v4i16((LAS v4i16_t*)p)); }

template <bool SINK>
__device__ __forceinline__ void attn_wave_tile(const bf16* __restrict__ QKV, int rowbase, int dil, int r, int m0, int qcol, int kcol, int vcol, float sink2, LAS unsigned char* vst, int lane,
                                               float& m_out, float& l_out, f32x16& o0, f32x16& o1) {
    constexpr int MAXD = SINK ? WA - 1 : 128;
    const int i = lane & 31, hi = lane >> 5;
    const int nkt = (m0 >> 5) + 1 < 5 ? (m0 >> 5) + 1 : 5;
    bf16x8 qf[4], kf[5][4]; v4u vv[3][4];
    { const bf16* qp = QKV + (size_t)(rowbase + (m0 + i) * dil + r) * INC + qcol + 32 * hi;
#pragma unroll
      for (int s = 0; s < 4; ++s) qf[s] = *(const bf16x8*)(qp + 8 * s); }
#pragma unroll
    for (int step = 0; step < 5; ++step) {
        const int mk0 = m0 - (step < nkt ? 32 * step : 0);
        const bf16* kp = QKV + (size_t)(rowbase + (mk0 + i) * dil + r) * INC + kcol + 32 * hi;
#pragma unroll
        for (int s = 0; s < 4; ++s) kf[step][s] = *(const bf16x8*)(kp + 8 * s);
        if (step < 3) {
#pragma unroll
        for (int it = 0; it < 4; ++it) vv[step][it] = *(const v4u*)(QKV + (size_t)(rowbase + (mk0 + (lane >> 3) + 8 * it) * dil + r) * INC + vcol + 8 * (lane & 7)); }
    }
    float mrun = SINK ? sink2 : -INFINITY, lrun = SINK ? (hi == 0 ? 1.f : 0.f) : 0.f;
#pragma unroll
    for (int x = 0; x < 16; ++x) { o0[x] = 0.f; o1[x] = 0.f; }
    const int tr_off = (4 * hi + ((lane & 15) >> 2)) * 128 + (16 * ((lane >> 4) & 1) + 4 * (lane & 3)) * 2;
#pragma unroll
    for (int step = 0; step < 5; ++step) {
        if (step < nkt) {
        const int kt = 4 - step;
        f32x16 s;
#pragma unroll
        for (int x = 0; x < 16; ++x) s[x] = 0.f;
#pragma unroll
        for (int ss = 0; ss < 4; ++ss) s = __builtin_amdgcn_mfma_f32_32x32x16_bf16(kf[step][ss], qf[ss], s, 0, 0, 0);
        asm volatile("" ::: "memory");
#pragma unroll
        for (int it = 0; it < 4; ++it) *(LAS v4u*)(vst + ((lane >> 3) + 8 * it) * 128 + (lane & 7) * 16) = vv[step % 3][it];
        if (step < 2) { const int mk3 = m0 - (step + 3 < nkt ? 32 * (step + 3) : 0);
#pragma unroll
            for (int it = 0; it < 4; ++it) vv[step][it] = *(const v4u*)(QKV + (size_t)(rowbase + (mk3 + (lane >> 3) + 8 * it) * dil + r) * INC + vcol + 8 * (lane & 7)); }
        asm volatile("s_waitcnt lgkmcnt(0)" ::: "memory");
        if (kt == 4 || kt == 0) {
            const int dbase = 128 - 32 * kt + i;
#pragma unroll
            for (int x = 0; x < 16; ++x) { const int j = (x & 3) + 8 * (x >> 2) + 4 * hi; const int dist = dbase - j;
                s[x] = (dist >= 0 && dist <= MAXD) ? s[x] : -INFINITY; }
        }
        float mx = s[0];
#pragma unroll
        for (int x = 1; x < 16; ++x) mx = fmaxf(mx, s[x]);
        mx = xmax32(mx);
        const float mn = fmaxf(mrun, mx);
        const float corr = ex2(mrun - mn);
        float ps = 0.f;
#pragma unroll
        for (int x = 0; x < 16; ++x) { s[x] = ex2(s[x] - mn); ps += s[x]; }
        lrun = lrun * corr + ps; mrun = mn;
        o0 = o0 * corr; o1 = o1 * corr;
        v4u p0u, p1u;
        p0u.x = cvtpk(s[0], s[1]); p0u.y = cvtpk(s[2], s[3]); p0u.z = cvtpk(s[4], s[5]); p0u.w = cvtpk(s[6], s[7]);
        p1u.x = cvtpk(s[8], s[9]); p1u.y = cvtpk(s[10], s[11]); p1u.z = cvtpk(s[12], s[13]); p1u.w = cvtpk(s[14], s[15]);
        const bf16x8 pa0 = __builtin_bit_cast(bf16x8, p0u), pa1 = __builtin_bit_cast(bf16x8, p1u);
#pragma unroll
        for (int dt = 0; dt < 2; ++dt) {
#pragma unroll
            for (int j = 0; j < 2; ++j) {
                const LAS unsigned char* a = vst + tr_off + j * 16 * 128 + dt * 64;
                const s16x4 lo = vtr(a), hh = vtr(a + 8 * 128);
                const bf16x8 vf = (bf16x8){lo[0], lo[1], lo[2], lo[3], hh[0], hh[1], hh[2], hh[3]};
                if (dt == 0) o0 = __builtin_amdgcn_mfma_f32_32x32x16_bf16(vf, j == 0 ? pa0 : pa1, o0, 0, 0, 0);
                else         o1 = __builtin_amdgcn_mfma_f32_32x32x16_bf16(vf, j == 0 ? pa0 : pa1, o1, 0, 0, 0);
            }
        }
        asm volatile("" ::: "memory");
        }
    }
    l_out = xsum32(lrun); m_out = mrun;
}

__device__ __forceinline__ void finalize_store(const f32x16& o0, const f32x16& o1, float l, bf16* orow, float* ssqp, int hi) {
    const float inv = 1.0f / l; float ss = 0.f;
#pragma unroll
    for (int dt = 0; dt < 2; ++dt)
#pragma unroll
        for (int gq = 0; gq < 4; ++gq) {
            const float a = (dt == 0 ? o0[4 * gq] : o1[4 * gq]) * inv, b = (dt == 0 ? o0[4 * gq + 1] : o1[4 * gq + 1]) * inv, c = (dt == 0 ? o0[4 * gq + 2] : o1[4 * gq + 2]) * inv, d = (dt == 0 ? o0[4 * gq + 3] : o1[4 * gq + 3]) * inv;
            ss += (a * a + b * b) + (c * c + d * d);
            u32x2 w; w.x = pk2(a, b); w.y = pk2(c, d);
            *(u32x2*)(orow + 32 * dt + 8 * gq + 4 * hi) = w; }
    ss = xsum32(ss);
    if (hi == 0) *ssqp = ss;
}

struct SSt { float m, l; f32x4 o; };
__device__ __forceinline__ void s_step(SSt& st, const f32x4& q4, const f32x4& k4, const f32x4& v4, bool valid) {
    float s = (q4.x * k4.x + q4.y * k4.y) + (q4.z * k4.z + q4.w * k4.w);
    s = sum16(s);
    s = valid ? s : -INFINITY;
    const float mn = fmaxf(st.m, s);
    const float corr = (mn == -INFINITY) ? 1.f : ex2(st.m - mn);
    const float p = valid ? ex2(s - mn) : 0.f;
    st.l = st.l * corr + p; st.o = st.o * corr + v4 * p; st.m = mn;
}
__device__ __forceinline__ void s_merge(SSt& st) {
#pragma unroll
    for (int x = 16; x <= 32; x <<= 1) {
        const float m2 = __shfl_xor(st.m, x), l2 = __shfl_xor(st.l, x);
        f32x4 o2; o2.x = __shfl_xor(st.o.x, x); o2.y = __shfl_xor(st.o.y, x); o2.z = __shfl_xor(st.o.z, x); o2.w = __shfl_xor(st.o.w, x);
        const float mn = fmaxf(st.m, m2);
        const float a = (st.m == -INFINITY) ? 0.f : ex2(st.m - mn), b = (m2 == -INFINITY) ? 0.f : ex2(m2 - mn);
        st.l = st.l * a + l2 * b; st.o = st.o * a + o2 * b; st.m = mn;
    }
}
__device__ __forceinline__ f32x4 load_q4(const bf16* QKV, int row, int qcol, int c) {
    const u32x2 w = *(const u32x2*)(QKV + (size_t)row * INC + qcol + 8 * (c & 7) + 4 * (c >> 3));
    f32x4 q; q.x = bf2f(w.x & 0xffffu); q.y = bf2f(w.x >> 16); q.z = bf2f(w.y & 0xffffu); q.w = bf2f(w.y >> 16); return q;
}
__device__ __forceinline__ void s_store(const SSt& st, bf16* orow, float* ssqp, int lane) {
    const int c = lane & 15; const float inv = 1.0f / st.l; const f32x4 o = st.o * inv;
    float ss = (o.x * o.x + o.y * o.y) + (o.z * o.z + o.w * o.w);
    ss = sum16(ss);
    if (lane < 16) { u32x2 w; w.x = pk2(o.x, o.y); w.y = pk2(o.z, o.w); *(u32x2*)(orow + 4 * c) = w; }
    if (lane == 0) *ssqp = ss;
}


__device__ __forceinline__ int q_pop(gu32* head, volatile LAS unsigned* slot, int tid) {
    if (tid == 0) *slot = __hip_atomic_fetch_add(head, 1u, RLX_AGENT);
    __syncthreads();
    const int v = (int)*slot;
    __syncthreads();
    return __builtin_amdgcn_readfirstlane(v);
}

constexpr int SUB_F4 = 512, SUB_PER_REG = (WB - DS) * 512 / 4 / SUB_F4, NSUBS = 2 * DB * SUB_PER_REG, RANGE = 16, NRANGES = NSUBS / RANGE;
static_assert(SUB_PER_REG == 511 && NSUBS % RANGE == 0, "copy chunking");
__device__ __forceinline__ unsigned wave_pop_issue(gu32* head, int lane) { unsigned v = 0u; if (lane == 0) v = __hip_atomic_fetch_add(head, 1u, RLX_AGENT); return v; }
__device__ __forceinline__ void sub_ptrs(int f, const float* cbk, const float* cbv, float* out, int lane, const f32x4*& src, f32x4*& dst) {
    const int reg = f / SUB_PER_REG, sidx = f - reg * SUB_PER_REG, arr = reg >> 7, b = reg & (DB - 1);
    const size_t bo = (size_t)b * WB * 512;
    src = (const f32x4*)((arr ? cbv : cbk) + bo + DS * 512) + sidx * SUB_F4 + lane; dst = (f32x4*)(out + (arr ? O_SBV : O_SBK) + bo) + sidx * SUB_F4 + lane;
}
#define CP_LOAD(buf, f) do { const f32x4* s_; f32x4* d_; sub_ptrs((f), cbk, cbv, out, lane, s_, d_); _Pragma("unroll") for (int k_ = 0; k_ < 8; ++k_) buf[k_] = __builtin_nontemporal_load(s_ + 64 * k_); } while (0)
#define CP_STORE(buf, f) do { const f32x4* s_; f32x4* d_; sub_ptrs((f), cbk, cbv, out, lane, s_, d_); _Pragma("unroll") for (int k_ = 0; k_ < 8; ++k_) __builtin_nontemporal_store(buf[k_], d_ + 64 * k_); } while (0)
__device__ __forceinline__ void copy_drain(gu32* head, gu32* pause, int lane, const float* cbk, const float* cbv, float* out) {
    int c = __builtin_amdgcn_readfirstlane((int)wave_pop_issue(head, lane));
    if (c >= NRANGES) return;
    f32x4 b0[8], b1[8], b2[8], b3[8];
    { const int f0 = c * RANGE; CP_LOAD(b0, f0); CP_LOAD(b1, f0 + 1); CP_LOAD(b2, f0 + 2); CP_LOAD(b3, f0 + 3); }
    for (;;) {
        if (pause) { unsigned sp = 0; while (__hip_atomic_load(pause, RLX_AGENT) != 0u && ++sp < (1u << 16)) __builtin_amdgcn_s_sleep(32); }
        const unsigned vnext = wave_pop_issue(head, lane);
        const int f0 = c * RANGE;
        CP_STORE(b0, f0 + 0); CP_LOAD(b0, f0 + 4);   CP_STORE(b1, f0 + 1); CP_LOAD(b1, f0 + 5);   CP_STORE(b2, f0 + 2); CP_LOAD(b2, f0 + 6);   CP_STORE(b3, f0 + 3); CP_LOAD(b3, f0 + 7);
        CP_STORE(b0, f0 + 4); CP_LOAD(b0, f0 + 8);   CP_STORE(b1, f0 + 5); CP_LOAD(b1, f0 + 9);   CP_STORE(b2, f0 + 6); CP_LOAD(b2, f0 + 10);  CP_STORE(b3, f0 + 7); CP_LOAD(b3, f0 + 11);
        CP_STORE(b0, f0 + 8); CP_LOAD(b0, f0 + 12);  CP_STORE(b1, f0 + 9); CP_LOAD(b1, f0 + 13);  CP_STORE(b2, f0 + 10); CP_LOAD(b2, f0 + 14); CP_STORE(b3, f0 + 11); CP_LOAD(b3, f0 + 15);
        const int cn = __builtin_amdgcn_readfirstlane((int)vnext);
        if (cn >= NRANGES) { CP_STORE(b0, f0 + 12); CP_STORE(b1, f0 + 13); CP_STORE(b2, f0 + 14); CP_STORE(b3, f0 + 15); break; }
        const int g0 = cn * RANGE;
        CP_STORE(b0, f0 + 12); CP_LOAD(b0, g0 + 0);  CP_STORE(b1, f0 + 13); CP_LOAD(b1, g0 + 1);  CP_STORE(b2, f0 + 14); CP_LOAD(b2, g0 + 2);  CP_STORE(b3, f0 + 15); CP_LOAD(b3, g0 + 3);
        c = cn;
    }
}

__device__ __forceinline__ void unit_A(int unit, const bf16* QKV, const float* sinks, bf16* OB, float* SSQ, LAS unsigned char* vst, int wave, int lane) {
    const int hq = unit & 7, R = (unit >> 3) & 15, b = unit >> 7, i = lane & 31, hi = lane >> 5;
    const float sink2 = sinks[hq] * LOG2E;
#pragma unroll 1
    for (int k = 0; k < 2; ++k) { const int m0 = 512 * R + 32 * (wave + 8 * k);
        float m, l; f32x16 o0, o1;
        attn_wave_tile<true>(QKV, b * SEQ, 1, 0, m0, 64 * hq, 512 + 64 * (hq >> 2), 640 + 64 * (hq >> 2), sink2, vst, lane, m, l, o0, o1);
        const int row = b * SEQ + m0 + i;
        finalize_store(o0, o1, l, OB + (size_t)row * D + 64 * hq, SSQ + (size_t)row * 16 + hq, hi); }
}
__device__ __forceinline__ void unit_B(int unit, const bf16* QKV, bf16* OB, float* SSQ, LAS unsigned char* lds, LAS unsigned char* vst, int wave, int lane) {
    LAS unsigned char* Ost = lds;
    LAS f32x2* ML = (LAS f32x2*)(lds + 65536);
    const int hb = unit & 7, R = (unit >> 3) & 15, b = unit >> 7, i = lane & 31, hi = lane >> 5;
#pragma unroll 1
    for (int br = 0; br < 3; ++br) {
        const int dil = br == 0 ? 1 : br == 1 ? 4 : 16;
#pragma unroll 1
        for (int k = 0; k < 2; ++k) { const int ti = wave + 8 * k;
            const int r = br == 0 ? 0 : br == 1 ? (ti >> 2) : ti;
            const int m0 = br == 0 ? 512 * R + 32 * ti : br == 1 ? 128 * R + 32 * (ti & 3) : 32 * R;
            float m, l; f32x16 o0, o1;
            attn_wave_tile<false>(QKV, b * SEQ, dil, r, m0, 768 + 64 * hb, 1280 + 64 * hb, 1792 + 64 * hb, 0.f, vst, lane, m, l, o0, o1);
            const int t = (m0 + i) * dil + r, ql = t - 512 * R;
            LAS unsigned char* orow = Ost + ql * 128;
            const int gx = (((ql >> 1) ^ (ql >> 5)) & 15) << 3, hb8 = 8 * hi;
            if (br > 0) {
                const f32x2 ms = ML[ql]; const float mn = fmaxf(ms.x, m), a = ex2(ms.x - mn), c = ex2(m - mn);
                l = ms.y * a + l * c; m = mn;
#pragma unroll
                for (int dt = 0; dt < 2; ++dt)
#pragma unroll
                    for (int gq = 0; gq < 4; ++gq) { const u32x2 w = *(const LAS u32x2*)(orow + (((32 * dt + 8 * gq) * 2 + hb8) ^ gx));
                        const float s0 = bf2f(w.x & 0xffffu), s1 = bf2f(w.x >> 16), s2 = bf2f(w.y & 0xffffu), s3 = bf2f(w.y >> 16);
                        if (dt == 0) { o0[4 * gq] = o0[4 * gq] * c + s0 * a; o0[4 * gq + 1] = o0[4 * gq + 1] * c + s1 * a; o0[4 * gq + 2] = o0[4 * gq + 2] * c + s2 * a; o0[4 * gq + 3] = o0[4 * gq + 3] * c + s3 * a; }
                        else { o1[4 * gq] = o1[4 * gq] * c + s0 * a; o1[4 * gq + 1] = o1[4 * gq + 1] * c + s1 * a; o1[4 * gq + 2] = o1[4 * gq + 2] * c + s2 * a; o1[4 * gq + 3] = o1[4 * gq + 3] * c + s3 * a; } }
            }
            if (br < 2) {
                if (hi == 0) ML[ql] = (f32x2){m, l};
#pragma unroll
                for (int dt = 0; dt < 2; ++dt)
#pragma unroll
                    for (int gq = 0; gq < 4; ++gq) { u32x2 w;
                        if (dt == 0) { w.x = pk2(o0[4 * gq], o0[4 * gq + 1]); w.y = pk2(o0[4 * gq + 2], o0[4 * gq + 3]); } else { w.x = pk2(o1[4 * gq], o1[4 * gq + 1]); w.y = pk2(o1[4 * gq + 2], o1[4 * gq + 3]); }
                        *(LAS u32x2*)(orow + (((32 * dt + 8 * gq) * 2 + hb8) ^ gx)) = w; }
            } else {
                const int row = b * SEQ + t;
                finalize_store(o0, o1, l, OB + (size_t)row * D + 512 + 64 * hb, SSQ + (size_t)row * 16 + 8 + hb, hi);
            }
        }
        __syncthreads();
    }
}
__device__ __forceinline__ void s_step_w(SSt& st, const f32x4& q4, const f32x4& k4, const f32x4& v4, float w) {
    float s = sum16((q4.x * k4.x + q4.y * k4.y) + (q4.z * k4.z + q4.w * k4.w));
    const bool valid = w > 0.f;
    s = valid ? s : -INFINITY;
    const float mn = fmaxf(st.m, s);
    const float corr = (mn == -INFINITY) ? 1.f : ex2(st.m - mn);
    const float p = valid ? w * ex2(s - mn) : 0.f;
    st.l = st.l * corr + p; st.o = st.o * corr + v4 * p; st.m = mn;
}
__device__ __forceinline__ void s_combine(SSt& a, const SSt& b, bool take) {
    const float mn = fmaxf(a.m, b.m);
    const float ca = (a.m == -INFINITY) ? 0.f : ex2(a.m - mn), cb = (b.m == -INFINITY) ? 0.f : ex2(b.m - mn);
    if (take) { a.l = a.l * ca + b.l * cb; a.o = a.o * ca + b.o * cb; a.m = mn; }
}
__device__ __forceinline__ void sample_B4(int item, const bf16* QKV, const float* cbk, const float* cbv, const float* out, bf16* OB, float* SSQ, int lane) {
    const int c = lane & 15, g = lane >> 4, hb = item & 7, b = item >> 3, row0 = MP + b * DS;
    f32x4 q[4];
#pragma unroll
    for (int i = 0; i < 4; ++i) q[i] = load_q4(QKV, row0 + i, 768 + 64 * hb, c);
    const f32x4 qg = g == 0 ? q[0] : g == 1 ? q[1] : g == 2 ? q[2] : q[3];
    const size_t base = (((size_t)b * WB) * 8 + hb) * 64 + 4 * c;
    SSt sg; sg.m = -INFINITY; sg.l = 0.f; sg.o = (f32x4){0.f, 0.f, 0.f, 0.f};
#pragma unroll 1
    for (int s0 = 0; s0 < 192; s0 += 12) {
        f32x4 k4[12], v4[12];
#pragma unroll
        for (int u = 0; u < 12; ++u) { const int st_ = s0 + u, p = st_ < 96 ? 16 * st_ + g : 1536 + 4 * (st_ - 96) + g;
            k4[u] = __builtin_nontemporal_load((const f32x4*)(cbk + base + (size_t)p * 512)); v4[u] = __builtin_nontemporal_load((const f32x4*)(cbv + base + (size_t)p * 512)); }
#pragma unroll
        for (int u = 0; u < 12; ++u) { const int st_ = s0 + u, p = st_ < 96 ? 16 * st_ + g : 1536 + 4 * (st_ - 96) + g;
            const float w = (st_ >= 96 && (p & 15) == g) ? 2.f : 1.f;
            s_step_w(sg, qg, k4[u], v4[u], w); }
    }
    SSt st[4];
#pragma unroll
    for (int i = 0; i < 4; ++i) { st[i].m = -INFINITY; st[i].l = 0.f; st[i].o = (f32x4){0.f, 0.f, 0.f, 0.f}; }
#pragma unroll 1
    for (int s0 = 0; s0 < 32; s0 += 8) {
        f32x4 k4[8], v4[8];
#pragma unroll
        for (int u = 0; u < 8; ++u) { const int p = 1920 + 4 * (s0 + u) + g;
            k4[u] = __builtin_nontemporal_load((const f32x4*)(cbk + base + (size_t)p * 512)); v4[u] = __builtin_nontemporal_load((const f32x4*)(cbv + base + (size_t)p * 512)); }
#pragma unroll
        for (int u = 0; u < 8; ++u) { const int p = 1920 + 4 * (s0 + u) + g;
#pragma unroll
            for (int i = 0; i < 4; ++i) { const float w = (p >= 1920 + i ? 1.f : 0.f) + ((p & 3) == i ? 1.f : 0.f) + ((p & 15) == i ? 1.f : 0.f);
                s_step_w(st[i], q[i], k4[u], v4[u], w); } }
    }
    {
        const size_t o = (((size_t)b * WB + WB - DS + g) * 8 + hb) * 64 + 4 * c;
        const f32x4 kn = *(const f32x4*)(out + O_SBK + o), vn = *(const f32x4*)(out + O_SBV + o);
#pragma unroll
        for (int i = 0; i < 4; ++i) { const float w = (g <= i ? 1.f : 0.f) + (g == i ? 2.f : 0.f); s_step_w(st[i], q[i], kn, vn, w); }
    }
#pragma unroll
    for (int i = 0; i < 4; ++i) { s_combine(st[i], sg, g == i); s_merge(st[i]);
        s_store(st[i], OB + (size_t)(row0 + i) * D + 512 + 64 * hb, SSQ + (size_t)(row0 + i) * 16 + 8 + hb, lane); }
}

__device__ __forceinline__ void sample_A4(int item, const bf16* QKV, const float* cak, const float* cav, const float* out, const float* sinks, bf16* OB, float* SSQ, int lane) {
    const int c = lane & 15, g = lane >> 4, hpair = item & 1, hkv = (item >> 1) & 1, b = item >> 2, row0 = MP + b * DS, hq0 = 4 * hkv + 2 * hpair;
    f32x4 q[4][2]; SSt st[4][2];
#pragma unroll
    for (int i = 0; i < 4; ++i)
#pragma unroll
        for (int hh = 0; hh < 2; ++hh) { q[i][hh] = load_q4(QKV, row0 + i, 64 * (hq0 + hh), c); st[i][hh].m = -INFINITY; st[i][hh].l = 0.f; st[i][hh].o = (f32x4){0.f, 0.f, 0.f, 0.f}; }
    const size_t base = (((size_t)b * WA) * 2 + hkv) * 64 + 4 * c;
#pragma unroll 1
    for (int s0 = 0; s0 < 32; s0 += 8) {
        f32x4 k4[8], v4[8];
#pragma unroll
        for (int u = 0; u < 8; ++u) { const int j = 4 * (s0 + u) + g;
            k4[u] = __builtin_nontemporal_load((const f32x4*)(cak + base + (size_t)j * 128)); v4[u] = __builtin_nontemporal_load((const f32x4*)(cav + base + (size_t)j * 128)); }
#pragma unroll
        for (int u = 0; u < 8; ++u) { const int j = 4 * (s0 + u) + g;
#pragma unroll
            for (int i = 0; i < 4; ++i) { const float w = j >= i + 1 ? 1.f : 0.f;
#pragma unroll
                for (int hh = 0; hh < 2; ++hh) s_step_w(st[i][hh], q[i][hh], k4[u], v4[u], w); } }
    }
    {
        const size_t o = (((size_t)b * WA + WA - DS + g) * 2 + hkv) * 64 + 4 * c;
        const f32x4 kn = *(const f32x4*)(out + O_SAK + o), vn = *(const f32x4*)(out + O_SAV + o);
#pragma unroll
        for (int i = 0; i < 4; ++i) { const float w = g <= i ? 1.f : 0.f;
#pragma unroll
            for (int hh = 0; hh < 2; ++hh) s_step_w(st[i][hh], q[i][hh], kn, vn, w); }
    }
#pragma unroll
    for (int i = 0; i < 4; ++i)
#pragma unroll
        for (int hh = 0; hh < 2; ++hh) { SSt& t = st[i][hh]; s_merge(t);
            const float sk = sinks[hq0 + hh] * LOG2E, mn = fmaxf(t.m, sk), a = ex2(t.m - mn); t.l = t.l * a + ex2(sk - mn); t.o = t.o * a; t.m = mn;
            s_store(t, OB + (size_t)(row0 + i) * D + 64 * (hq0 + hh), SSQ + (size_t)(row0 + i) * 16 + hq0 + hh, lane); }
}

struct Args { const float* in[21]; float* out; unsigned char* ws; };
__global__ void __launch_bounds__(NTHREADS, 2) mk_fwd(Args args) {
    extern __shared__ __attribute__((aligned(16))) unsigned char lds_raw[];
    LAS unsigned char* lds = (LAS unsigned char*)lds_raw;
    volatile LAS unsigned* MISC = (volatile LAS unsigned*)(lds + MISC_OFF);
    const int tid = threadIdx.x, lane = tid & 63, wave = __builtin_amdgcn_readfirstlane(tid >> 6);
    const int bx = blockIdx.x;
    constexpr int G = NCOMP;
    const int gw = bx * NWAVES + wave; constexpr int NGW = G * NWAVES;
    unsigned char* ws = args.ws;
    gu32* ctl = (gu32*)(ws + WS_CTL);
    const float* xp = args.in[0]; const float* xs = args.in[1]; const float* cp = args.in[2]; const float* cs = args.in[3];
    const float* cak = args.in[4]; const float* cav = args.in[5]; const float* cbk = args.in[6]; const float* cbv = args.in[7];
    const float* w_ada = args.in[8]; const float* b_ada = args.in[9]; const float* g_attn = args.in[10]; const float* w_in = args.in[11];
    const float* sinks = args.in[12]; const float* g_oa = args.in[13]; const float* g_ob = args.in[14]; const float* w_o = args.in[15];
    const float* g_ffn = args.in[16]; const float* w_gate = args.in[17]; const float* w_up = args.in[18]; const float* w_down = args.in[19];
    const float* g_final = args.in[20];
    float* out = args.out;
    float* MOD = (float*)(ws + WS_MOD); float* COS = (float*)(ws + WS_COS); float* SIN = (float*)(ws + WS_SIN); float* SSQ = (float*)(ws + WS_SSQ);
    bf16* Win_t = (bf16*)(ws + WS_WIN); bf16* Wo_t = (bf16*)(ws + WS_WO); bf16* Wgu_t = (bf16*)(ws + WS_WGU); bf16* Wd_t = (bf16*)(ws + WS_WD);
    bf16* XN = (bf16*)(ws + WS_XN); bf16* QKV = (bf16*)(ws + WS_QKV); bf16* OB = (bf16*)(ws + WS_OB); bf16* X1 = (bf16*)(ws + WS_X1); bf16* HM = (bf16*)(ws + WS_HM); bf16* X2 = (bf16*)(ws + WS_X2);

    for (int u = tid; u < (LDS_BYTES - LDSCTL_OFF) / 4; u += NTHREADS) ((LAS unsigned*)(lds + LDSCTL_OFF))[u] = 0u;
    __syncthreads();
    if (bx >= NCOMP) {
        const int cb = bx - NCOMP;
        {
            constexpr int PA = (WA - DS) * 128 / 4;
            for (int e = cb * NTHREADS + tid; e < 2 * DB * PA; e += NCOPY * NTHREADS) { const int arr = e / (DB * PA), rem = e - arr * (DB * PA), b = rem / PA, i4 = rem - b * PA;
                const size_t bo = (size_t)b * WA * 128;
                ((f32x4*)(out + (arr ? O_SAV : O_SAK) + bo))[i4] = ((const f32x4*)((arr ? cav : cak) + bo + DS * 128))[i4]; }
        }
        copy_drain(ctl + CW_COPY_HEAD, ctl + CW_PAUSE, lane, cbk, cbv, out);
        return;
    }
    XcdBarrier bar = xcd_barrier_post((unsigned*)(ctl + CW_BAR), MISC + 8);

    if (bx < NMOD / 32) ada_block(lds, bx, cp, cs, w_ada, b_ada, MOD, tid, wave, lane);
    {
        LAS float* scr = (LAS float*)(lds + RING_OFF + wave * 16384);
        constexpr int I_IN = (D / 64) * (INC / 32), I_O = (D / 64) * (D / 32), I_G = (D / 64) * (FF / 32), I_D = (FF / 64) * (D / 32);
        const int rw = NGW - 1 - gw;
        transpose_matrix(w_in, D, INC, Win_t, RmIn(), nullptr, nullptr, scr, rw, NGW, I_IN, lane);
        transpose_matrix(w_gate, D, FF, Wgu_t, RmGate(), nullptr, nullptr, scr, rw, NGW, I_G, lane);
        transpose_matrix(w_up, D, FF, Wgu_t, RmUp(), nullptr, nullptr, scr, rw, NGW, I_G, lane);
        transpose_matrix(w_down, FF, D, Wd_t, RmId(), nullptr, nullptr, scr, rw, NGW, I_D, lane);
        transpose_matrix(w_o, D, D, Wo_t, RmId(), g_oa, g_ob, scr, rw, NGW, I_O, lane);
        for (int e = bx * NTHREADS + tid; e < NPOS * 32; e += G * NTHREADS) rope_entry(e, COS, SIN);
    }
    xcd_barrier(bar);
    for (int row = gw; row < MT; row += NGW) {
        const float* xrow = row < MP ? xp + (size_t)row * D : xs + (size_t)(row - MP) * D; const float* mr = MOD + (size_t)mod_row(row) * NMOD;
        normmod_row(xrow, g_attn, mr, mr + 1024, XN + (size_t)row * D, lane);
    }
    xcd_barrier(bar);
    {
        pg8::Gemm g{XN, Win_t, MT, INC, D}; pg8::StaticOrder S; S.init(MT, INC, G, bx);
        pg8::EpiQKV E{QKV, COS, SIN, out};
        pg8::gemm_phase<pg8::EpiQKV, pg8::StaticOrder, true, true>(lds + RING_OFF, g, S, E);
    }
    xcd_barrier(bar);
    {
        LAS unsigned char* vst = lds + 73728 + wave * 4096;
        const unsigned xme = xb_xcc_id() & 7u;
        for (unsigned tq = 0; tq < 8u; ++tq) { const int x = (int)((xme + tq) & 7u);
            for (;;) {
                const int e = q_pop(ctl + CW_ATTQ + 64 * x, MISC + 17, tid);
                if (e >= 96) break;
                const int k = e / 6, r = e - 6 * k;
                int ln = lane; asm volatile("" : "+v"(ln));
                const int pr = 2 * x + ((r - 1) & 1), unit = ((pr >> 3) << 7) | (k << 3) | (pr & 7);
                if (r == 0) sample_B4((16 * x + k) * 8 + wave, QKV, cbk, cbv, out, OB, SSQ, ln);
                else if (r < 3) unit_B(unit, QKV, OB, SSQ, lds, vst, wave, ln);
                else if (r < 5) unit_A(unit, QKV, sinks, OB, SSQ, vst, wave, ln);
                else if ((k & 1) == 0) sample_A4((8 * x + (k >> 1)) * 8 + wave, QKV, cak, cav, out, sinks, OB, SSQ, ln);
            }
        }
    }
    xcd_barrier(bar);
    {
        pg8::Gemm g{OB, Wo_t, MT, D, D}; pg8::StaticOrder S; S.init(MT, D, G, bx);
        LAS pg8::f32x2v* tab = (LAS pg8::f32x2v*)(lds + TAB_OFF);
        for (int ui = 0; ui < 2; ++ui) { pg8::Unit u;
            if (S.next(ui, u) && tid < 256) { const int row = u.pm * 256 + tid; const f32x4* sp = (const f32x4*)(SSQ + (size_t)row * 16);
                const f32x4 a0 = sp[0], a1 = sp[1], b0 = sp[2], b1 = sp[3];
                const float sa = ((a0.x + a0.y) + (a0.z + a0.w)) + ((a1.x + a1.y) + (a1.z + a1.w)), sb = ((b0.x + b0.y) + (b0.z + b0.w)) + ((b1.x + b1.y) + (b1.z + b1.w));
                const float ra = 1.f / sqrtf(sa * (1.f / 512.f) + EPS), rb = 1.f / sqrtf(sb * (1.f / 512.f) + EPS);
                tab[ui * 256 + tid] = (pg8::f32x2v){ra / rb, rb}; } }
        __syncthreads();
        pg8::EpiOut E{MOD, X1, tab, (unsigned*)(ctl + CW_PANEL4)};
        pg8::gemm_phase<pg8::EpiOut, pg8::StaticOrder, true, true>(lds + RING_OFF, g, S, E);
        for (;;) {
            const int item = q_pop(ctl + CW_P5_HEAD, MISC + 18, tid);
            if (item >= (MT / 256) * 8) break;
            const int pm = item >> 3;
            if (tid == 0) { unsigned sp = 0; while (__hip_atomic_load(ctl + CW_PANEL4 + 64 * pm, RLX_AGENT) < 32u && ++sp < (1u << 22)) __builtin_amdgcn_s_sleep(4);
                __builtin_amdgcn_fence(__ATOMIC_ACQUIRE, "agent"); asm volatile("s_waitcnt vmcnt(0)" ::: "memory"); }
            __syncthreads();
#pragma unroll 1
            for (int j = 0; j < 4; ++j) { const int row = item * 32 + wave * 4 + j; const float* mr = MOD + (size_t)mod_row(row) * NMOD;
                const float* xrow = row < MP ? xp + (size_t)row * D : xs + (size_t)(row - MP) * D;
                resid_normmod_row(xrow, X1 + (size_t)row * D, g_ffn, mr + 3072, mr + 4096, XN + (size_t)row * D, lane); }
        }
    }
    xcd_barrier(bar);
    {
        pg8::Gemm g{XN, Wgu_t, MT, 2 * FF, D}; pg8::StaticOrder S; S.init(MT, 2 * FF, G, bx);
        pg8::EpiGU E{HM};
        pg8::gemm_phase<pg8::EpiGU, pg8::StaticOrder, true, true>(lds + RING_OFF, g, S, E);
    }
    xcd_barrier(bar);
    {
        pg8::Gemm g{HM, Wd_t, MT, D, FF}; pg8::StaticOrder S; S.init(MT, D, G, bx);
        pg8::EpiDown E{X1, MOD, X2, (unsigned*)(ctl + CW_PANEL7)};
        pg8::gemm_phase<pg8::EpiDown, pg8::StaticOrder, true, true>(lds + RING_OFF, g, S, E);
        for (;;) {
            const int item = q_pop(ctl + CW_P8_HEAD, MISC + 19, tid);
            if (item >= (MT / 256) * 8) break;
            const int pm = item >> 3;
            if (tid == 0) { unsigned sp = 0; while (__hip_atomic_load(ctl + CW_PANEL7 + 64 * pm, RLX_AGENT) < 32u && ++sp < (1u << 22)) __builtin_amdgcn_s_sleep(4);
                __builtin_amdgcn_fence(__ATOMIC_ACQUIRE, "agent"); asm volatile("s_waitcnt vmcnt(0)" ::: "memory"); }
            __syncthreads();
#pragma unroll 1
            for (int j = 0; j < 4; ++j) { const int row = item * 32 + wave * 4 + j; final_row(X2 + (size_t)row * D, out + O_Y + (size_t)row * D, g_final, lane); }
        }
    }
    copy_drain(ctl + CW_COPY_HEAD, nullptr, lane, cbk, cbv, out);
}

extern "C" void kernel_launch(void* const* d_in, const int* in_sizes, int n_in, void* d_out, int out_size, void* d_ws, size_t ws_size, hipStream_t stream) {
    static int grid = 0;
    if (grid == 0) {
        if (n_in != 21 || (size_t)out_size != O_END || ws_size < WS_END) { fprintf(stderr, "kernel_launch: unexpected shapes (n_in %d, out %d, ws %zu); nothing launched\n", n_in, out_size, ws_size); grid = -1; return; }
        if (hipFuncSetAttribute((const void*)mk_fwd, hipFuncAttributeMaxDynamicSharedMemorySize, LDS_BYTES) != hipSuccess) { fprintf(stderr, "kernel_launch: hipFuncSetAttribute failed\n"); grid = -1; return; }
        int per_cu = 0;
        if (hipOccupancyMaxActiveBlocksPerMultiprocessor(&per_cu, (const void*)mk_fwd, NTHREADS, LDS_BYTES) != hipSuccess || per_cu < 1) fprintf(stderr, "kernel_launch: note: occupancy query reports %d workgroups per CU\n", per_cu);
        (void)hipGetLastError();
        grid = NGRID;
    }
    if (grid < 0) return;
    (void)in_sizes;
    if (hipMemsetAsync((char*)d_ws + WS_CTL, 0, CTL_ZERO_BYTES, stream) != hipSuccess) { fprintf(stderr, "kernel_launch: hipMemsetAsync failed\n"); return; }
    Args a{};
    for (int i = 0; i < 21; ++i) a.in[i] = (const float*)d_in[i];
    a.out = (float*)d_out; a.ws = (unsigned char*)d_ws;
    hipLaunchKernelGGL(mk_fwd, dim3(grid), dim3(NTHREADS), LDS_BYTES, stream, a);
    const hipError_t le = hipPeekAtLastError();
    if (le != hipSuccess) fprintf(stderr, "kernel_launch: launch failed: %s\n", hipGetErrorName(le));
}
```

```cpp
#include <hip/hip_runtime.h>
#include <cstdio>
#include <cstdint>

constexpr int D = 1024, SEQ = 8192, NB = 2, DB = 128, DS = 4;
constexpr int MP = NB * SEQ, MS = DB * DS, MT = MP + MS;
constexpr int INC = 2304, FF = 2816, NMOD = 6144, NMB = NB + DB;
constexpr int WA = 128, WB = 2048, NPOS = SEQ + DS;
constexpr float EPS = 1e-6f;
#ifndef NCOPY
#define NCOPY 56
#endif
constexpr int NGRID = 256, NCOMP = NGRID - NCOPY;
#define XB_NPART ((unsigned)NCOMP)
constexpr float C2 = 0.125f * 1.4426950408889634f;
constexpr float LOG2E = 1.4426950408889634f;
constexpr size_t O_Y = 0;
constexpr size_t O_PAK = (size_t)MT * D;
constexpr size_t O_PAV = O_PAK + (size_t)NB * WA * 128;
constexpr size_t O_PBK = O_PAV + (size_t)NB * WA * 128;
constexpr size_t O_PBV = O_PBK + (size_t)NB * WB * 512;
constexpr size_t O_SAK = O_PBV + (size_t)NB * WB * 512;
constexpr size_t O_SAV = O_SAK + (size_t)DB * WA * 128;
constexpr size_t O_SBK = O_SAV + (size_t)DB * WA * 128;
constexpr size_t O_SBV = O_SBK + (size_t)DB * WB * 512;
constexpr size_t O_END = O_SBV + (size_t)DB * WB * 512;
static_assert(O_END == 294191104ull, "output map");

__device__ __forceinline__ int mod_row(int r) { return r < MP ? (r >> 13) : NB + ((r - MP) >> 2); }
__device__ __forceinline__ int pos_of(int r) { return r < MP ? (r & (SEQ - 1)) : SEQ + ((r - MP) & 3); }

namespace pg8 {
#define PG8_LAS __attribute__((address_space(3)))
typedef unsigned short bf16_t;
typedef short bf16x8 __attribute__((ext_vector_type(8)));
typedef float f32x4 __attribute__((ext_vector_type(4)));
typedef unsigned u32x4 __attribute__((ext_vector_type(4)));
constexpr int BM = 256, BK = 64, HALF = 128, HTB = HALF * BK * 2  , STAGE_BYTES = 8 * HTB, NXCD = 8, WGM = 8;

__host__ __device__ __forceinline__ int lds_byte(int r, int c) { const int st = (r >> 4) * 2 + (c >> 5), rr = r & 15, cc = c & 31, ob = rr * 64 + cc * 2; return st * 1024 + (ob ^ (((ob >> 9) & 1) << 5)); }
__host__ __device__ __forceinline__ void stage_rc(int b, int& R, int& C) { const int st = b / 1024, sb = b % 1024, swz = sb ^ (((sb >> 9) & 1) << 5); R = (st >> 1) * 16 + swz / 64; C = (st & 1) * 32 + (swz % 64) / 2; }
__host__ __device__ __forceinline__ int perm32(int rho) { const int n = rho >> 4, i = rho & 15; return 8 * (i >> 2) + 4 * n + (i & 3); }

struct Unit { int pm, pn; };
struct Gemm { const bf16_t* A; const bf16_t* Bt; int M, N, K; };

struct StaticOrder {
    int nM, nN, nwg, G, c;
    __host__ __device__ void init(int M, int N, int G_, int c_) { nM = M / BM; nN = N / BM; nwg = nM * nN; G = G_; c = c_; }
    __host__ __device__ bool next(int i, Unit& u) const {
        const long L = (long)i * G + c; if (L >= nwg) return false;
        int wgid = (int)L; { const int q = nwg / NXCD, r = nwg % NXCD, xcd = wgid % NXCD, off = wgid / NXCD; wgid = (xcd < r ? xcd * (q + 1) : r * (q + 1) + (xcd - r) * q) + off; }
        const int nig = WGM * nN, gid = wgid / nig, fm = gid * WGM, gsz = (nM - fm) < WGM ? (nM - fm) : WGM;
        u.pm = fm + ((wgid % nig) % gsz); u.pn = (wgid % nig) / gsz; return true;
    }
    __device__ __forceinline__ void a_ready(const Unit&) const {}
    __device__ __forceinline__ void done(const Unit&) const {}
};


typedef float f32x2v __attribute__((ext_vector_type(2)));
typedef unsigned u32x2v __attribute__((ext_vector_type(2)));
__device__ __forceinline__ unsigned cvt_pk_bf16(float lo, float hi) { unsigned r; asm volatile("v_cvt_pk_bf16_f32 %0, %1, %2" : "=v"(r) : "v"(lo), "v"(hi)); return r; }

struct EpiQKV {
    static constexpr bool PERM = true, AFTER_DRAIN = false; static constexpr int MID_T = 0;
    bf16_t* QKV; const float* COS; const float* SIN; float* out;
    __device__ __forceinline__ void operator()(const f32x4 (&acc)[2][2][4][2], const Unit& u, int ui, int wr, int wc, int fr, int fq) const {
        (void)ui;
        const int rowt = u.pm * BM + wr * 64 + fr;
        const bool samp = u.pm >= MP / BM;
        const int i0 = 16 * (wc & 1) + 4 * fq;
#pragma unroll
        for (int bj = 0; bj < 2; ++bj) {
            const int pc = u.pn * BM + bj * HALF + wc * 32 + 8 * fq;
            const int h64 = u.pn * 4 + bj * 2 + (wc >> 1);
            const bool isq = h64 < 8 || (h64 >= 12 && h64 < 20);
            const bool isk = (h64 >= 8 && h64 < 10) || (h64 >= 20 && h64 < 28);
            const bool isA = h64 >= 8 && h64 < 12, isB = h64 >= 20;
            const bool isv = !isq && !isk;
            const int hk = isA ? (h64 & 1) : ((h64 - 20) & 7);
            float* cbase = out;
            if (isA) cbase = out + (samp ? (isk ? O_SAK : O_SAV) : (isk ? O_PAK : O_PAV));
            if (isB) cbase = out + (samp ? (isk ? O_SBK : O_SBV) : (isk ? O_PBK : O_PBV));
            const int off1 = isk ? i0 : (pc & 63), off2 = isk ? 32 + i0 : (pc & 63) + 4;
#pragma unroll
            for (int ai = 0; ai < 2; ++ai)
#pragma unroll
                for (int m = 0; m < 4; ++m) {
                    const int row = rowt + ai * HALF + m * 16;
                    f32x4 v0 = acc[ai][bj][m][0], v1 = acc[ai][bj][m][1];
                    if (!isv) {
                        const int pos = samp ? SEQ + (row & 3) : (row & (SEQ - 1));
                        const f32x4 cs = *(const f32x4*)(COS + pos * 32 + i0), sn = *(const f32x4*)(SIN + pos * 32 + i0);
                        const f32x4 a = v0 * cs - v1 * sn, b = v1 * cs + v0 * sn;
                        v0 = a; v1 = b;
                        if (isq) { v0 = v0 * C2; v1 = v1 * C2; }
                    }
                    u32x4 w; w.x = cvt_pk_bf16(v0[0], v0[1]); w.y = cvt_pk_bf16(v0[2], v0[3]); w.z = cvt_pk_bf16(v1[0], v1[1]); w.w = cvt_pk_bf16(v1[2], v1[3]);
                    *(u32x4*)(QKV + (size_t)row * INC + pc) = w;
                    if (isA || isB) {
                        long slot = -1;
                        if (samp) { const int bs = (row - MP) >> 2, ii = row & 3; slot = isA ? (long)(bs * WA + WA - DS + ii) * 2 : (long)(bs * WB + WB - DS + ii) * 8; }
                        else { const int b = u.pm >> 5, t = row & (SEQ - 1);
                            if (isA) { if (t >= SEQ - WA) slot = (long)(b * WA + t - (SEQ - WA)) * 2; }
                            else { if (t >= SEQ - WB) slot = (long)(b * WB + t - (SEQ - WB)) * 8; } }
                        if (slot >= 0) { float* dst = cbase + (slot + hk) * 64; __builtin_nontemporal_store(v0, (f32x4*)(dst + off1)); __builtin_nontemporal_store(v1, (f32x4*)(dst + off2)); }
                    }
                }
        }
    }
};

struct EpiOut {
    static constexpr bool PERM = false, AFTER_DRAIN = false; static constexpr int MID_T = 8;
    const float* mod; bf16_t* X1; const PG8_LAS f32x2v* tab; unsigned* pcnt;
    __device__ __forceinline__ void mid(f32x4 (&acc)[2][2][4][2], int ui, int wr, int fr) const {
#pragma unroll
        for (int ai = 0; ai < 2; ++ai)
#pragma unroll
            for (int m = 0; m < 4; ++m) { const float ratio = tab[(ui & 1) * 256 + ai * HALF + wr * 64 + m * 16 + fr].x;
#pragma unroll
                for (int bj = 0; bj < 2; ++bj)
#pragma unroll
                    for (int n = 0; n < 2; ++n) acc[ai][bj][m][n] = acc[ai][bj][m][n] * ratio; }
    }
    __device__ __forceinline__ void operator()(const f32x4 (&acc)[2][2][4][2], const Unit& u, int ui, int wr, int wc, int fr, int fq) const {
        const int col0 = u.pn * BM + wc * 32 + 4 * fq;
#pragma unroll
        for (int ai = 0; ai < 2; ++ai)
#pragma unroll
            for (int m = 0; m < 4; ++m) { const int rl = ai * HALF + wr * 64 + m * 16 + fr, row = u.pm * BM + rl; const float rb = tab[(ui & 1) * 256 + rl].y;
                const float* grow = mod + (size_t)mod_row(row) * NMOD + 2048;
#pragma unroll
                for (int bj = 0; bj < 2; ++bj)
#pragma unroll
                    for (int n = 0; n < 2; ++n) { const int col = col0 + bj * HALF + n * 16; const f32x4 g4 = *(const f32x4*)(grow + col);
                        const f32x4 o = g4 * (acc[ai][bj][m][n] * rb); u32x2v w; w.x = cvt_pk_bf16(o[0], o[1]); w.y = cvt_pk_bf16(o[2], o[3]);
                        __hip_atomic_store((__attribute__((address_space(1))) unsigned long long*)(X1 + (size_t)row * D + col), ((unsigned long long)w.y << 32) | w.x, __ATOMIC_RELAXED, __HIP_MEMORY_SCOPE_AGENT); } }
        asm volatile("s_waitcnt vmcnt(0)" ::: "memory");
        if ((threadIdx.x & 63) == 0) (void)__hip_atomic_fetch_add(pcnt + 64 * u.pm, 1u, __ATOMIC_RELAXED, __HIP_MEMORY_SCOPE_AGENT);
    }
};

struct EpiGU {
    static constexpr bool PERM = true, AFTER_DRAIN = false; static constexpr int MID_T = 0;
    bf16_t* HM;
    __device__ __forceinline__ float silu_mul(float g, float u) const { return g * u * __builtin_amdgcn_rcpf(1.0f + __builtin_amdgcn_exp2f(-LOG2E * g)); }
    __device__ __forceinline__ void operator()(const f32x4 (&acc)[2][2][4][2], const Unit& u, int ui, int wr, int wc, int fr, int fq) const {
        (void)ui;
        const int row0 = u.pm * BM + wr * 64 + fr, col = u.pn * HALF + wc * 32 + 8 * fq;
#pragma unroll
        for (int ai = 0; ai < 2; ++ai)
#pragma unroll
            for (int m = 0; m < 4; ++m) { const f32x4 g0 = acc[ai][0][m][0], g1 = acc[ai][0][m][1], u0 = acc[ai][1][m][0], u1 = acc[ai][1][m][1];
                u32x4 w; w.x = cvt_pk_bf16(silu_mul(g0[0], u0[0]), silu_mul(g0[1], u0[1])); w.y = cvt_pk_bf16(silu_mul(g0[2], u0[2]), silu_mul(g0[3], u0[3]));
                w.z = cvt_pk_bf16(silu_mul(g1[0], u1[0]), silu_mul(g1[1], u1[1])); w.w = cvt_pk_bf16(silu_mul(g1[2], u1[2]), silu_mul(g1[3], u1[3]));
                *(u32x4*)(HM + (size_t)(row0 + ai * HALF + m * 16) * FF + col) = w; }
    }
};

struct EpiDown {
    static constexpr bool PERM = false, AFTER_DRAIN = false; static constexpr int MID_T = 0;
    const bf16_t* X1; const float* mod; bf16_t* X2; unsigned* pcnt;
    __device__ __forceinline__ void operator()(const f32x4 (&acc)[2][2][4][2], const Unit& u, int ui, int wr, int wc, int fr, int fq) const {
        (void)ui;
        const int col0 = u.pn * BM + wc * 32 + 4 * fq;
#pragma unroll
        for (int ai = 0; ai < 2; ++ai)
#pragma unroll
            for (int m = 0; m < 4; ++m) { const int row = u.pm * BM + ai * HALF + wr * 64 + m * 16 + fr;
                const bf16_t* xrow = X1 + (size_t)row * D; const float* grow = mod + (size_t)mod_row(row) * NMOD + 5120;
#pragma unroll
                for (int bj = 0; bj < 2; ++bj)
#pragma unroll
                    for (int n = 0; n < 2; ++n) { const int col = col0 + bj * HALF + n * 16; const u32x2v xw = *(const u32x2v*)(xrow + col); const f32x4 g4 = *(const f32x4*)(grow + col);
                        const f32x4 x4 = (f32x4){__uint_as_float(xw.x << 16), __uint_as_float(xw.x & 0xffff0000u), __uint_as_float(xw.y << 16), __uint_as_float(xw.y & 0xffff0000u)};
                        const f32x4 o = x4 + g4 * acc[ai][bj][m][n]; u32x2v w; w.x = cvt_pk_bf16(o[0], o[1]); w.y = cvt_pk_bf16(o[2], o[3]);
                        __hip_atomic_store((__attribute__((address_space(1))) unsigned long long*)(X2 + (size_t)row * D + col), ((unsigned long long)w.y << 32) | w.x, __ATOMIC_RELAXED, __HIP_MEMORY_SCOPE_AGENT); } }
        asm volatile("s_waitcnt vmcnt(0)" ::: "memory");
        if ((threadIdx.x & 63) == 0) (void)__hip_atomic_fetch_add(pcnt + 64 * u.pm, 1u, __ATOMIC_RELAXED, __HIP_MEMORY_SCOPE_AGENT);
    }
};

template <class Epi, class Sched, bool ALIGN_EPI = false, bool SP2 = false>
__device__ __forceinline__ void gemm_phase(PG8_LAS unsigned char* lds, const Gemm g, const Sched& S, const Epi& E) {
    int tid_ = threadIdx.x; asm volatile("" : "+v"(tid_));
    const int tid = tid_, wid = __builtin_amdgcn_readfirstlane(tid >> 6), lane = tid & 63, wr = wid >> 2, wc = wid & 3, fr = lane & 15, fq = lane >> 4;
    const int K = g.K, nt = K / BK;
    unsigned voffA[2], voffB[2];
#pragma unroll
    for (int i = 0; i < 2; ++i) { int R, C; stage_rc(tid * 16 + i * 8192, R, C); const int Rb = Epi::PERM ? ((R & ~31) + perm32(R & 31)) : R;
        voffA[i] = (unsigned)(R * K + C) * 2u; voffB[i] = (unsigned)(Rb * K + C) * 2u; }
    const size_t kstep = (size_t)(BK * 2);
    const size_t hstep = (size_t)HALF * K * 2;
    const size_t tstep = 2 * hstep;
    const unsigned ldsw = (unsigned)wid * 1024u;
    const int aoff = lds_byte(wr * 64 + fr, fq * 8), boff = lds_byte(wc * 32 + fr, fq * 8);
#define PG8_SA(b, h) (((b) * 2 + (h)) * HTB)
#define PG8_SB(b, h) ((4 + (b) * 2 + (h)) * HTB)
#define PG8_STAGE(bufoff, gbase, voff) do { _Pragma("unroll") for (int _i = 0; _i < 2; ++_i) \
        __builtin_amdgcn_global_load_lds((const unsigned*)((const char*)(gbase) + (voff)[_i]), (PG8_LAS unsigned*)(lds + (bufoff) + ldsw + _i * 8192), 16, 0, 0); } while (0)
#define PG8_LDA(dst, b, h) do { _Pragma("unroll") for (int m = 0; m < 4; ++m) _Pragma("unroll") for (int k = 0; k < 2; ++k) dst[m][k] = *(const PG8_LAS bf16x8*)(lds + PG8_SA(b, h) + aoff + m * 2048 + k * 1024); } while (0)
#define PG8_LDB(dst, b, h) do { _Pragma("unroll") for (int n = 0; n < 2; ++n) _Pragma("unroll") for (int k = 0; k < 2; ++k) dst[n][k] = *(const PG8_LAS bf16x8*)(lds + PG8_SB(b, h) + boff + n * 2048 + k * 1024); } while (0)
#define PG8_MMA(ai, bj, At, Bt) do { __builtin_amdgcn_s_setprio(1); _Pragma("unroll") for (int m = 0; m < 4; ++m) _Pragma("unroll") for (int n = 0; n < 2; ++n) _Pragma("unroll") for (int k = 0; k < 2; ++k) \
        acc[ai][bj][m][n] = __builtin_amdgcn_mfma_f32_16x16x32_bf16(Bt[n][k], At[m][k], acc[ai][bj][m][n], 0, 0, 0); __builtin_amdgcn_s_setprio(0); } while (0)
#define PG8_WAIT_V(n) asm volatile("s_waitcnt vmcnt(" #n ")" ::: "memory")
#define PG8_WAIT_L(n) asm volatile("s_waitcnt lgkmcnt(" #n ")" ::: "memory")
#define PG8_BAR __builtin_amdgcn_s_barrier()
#define PG8_SCHED __builtin_amdgcn_sched_barrier(0)
    Unit cur, nxt; int ui = 0;
    if (!S.next(0, cur)) return;
    f32x4 acc[2][2][4][2];
#pragma unroll
    for (int a = 0; a < 2; ++a)
#pragma unroll
        for (int b = 0; b < 2; ++b)
#pragma unroll
            for (int m = 0; m < 4; ++m)
#pragma unroll
                for (int n = 0; n < 2; ++n) acc[a][b][m][n] = (f32x4){0.f, 0.f, 0.f, 0.f};
    bf16x8 At[4][2], B0[2][2], B1[2][2];
    const char* cA = (const char*)g.A + (size_t)cur.pm * tstep; const char* cB = (const char*)g.Bt + (size_t)cur.pn * tstep;
    S.a_ready(cur);
    if constexpr (SP2) {
        PG8_STAGE(PG8_SB(0, 0), cB, voffB); PG8_STAGE(PG8_SB(0, 1), cB + hstep, voffB); PG8_STAGE(PG8_SA(0, 0), cA, voffA); PG8_STAGE(PG8_SA(0, 1), cA + hstep, voffA);
        if (wr == 1) PG8_BAR;
        PG8_WAIT_V(2); PG8_BAR;
        PG8_STAGE(PG8_SB(1, 0), cB + kstep, voffB); PG8_STAGE(PG8_SA(1, 0), cA + kstep, voffA); PG8_STAGE(PG8_SB(1, 1), cB + hstep + kstep, voffB);
        PG8_WAIT_V(6); PG8_BAR;
    } else {
        PG8_STAGE(PG8_SB(0, 0), cB, voffB); PG8_STAGE(PG8_SA(0, 0), cA, voffA); PG8_STAGE(PG8_SB(0, 1), cB + hstep, voffB); PG8_STAGE(PG8_SA(0, 1), cA + hstep, voffA);
        if (wr == 1) PG8_BAR;
        PG8_WAIT_V(4); PG8_BAR;
        PG8_STAGE(PG8_SB(1, 0), cB + kstep, voffB); PG8_STAGE(PG8_SA(1, 0), cA + kstep, voffA); PG8_STAGE(PG8_SB(1, 1), cB + hstep + kstep, voffB);
        PG8_WAIT_V(6); PG8_BAR;
    }
    for (;;) {
        const bool has_next = S.next(ui + 1, nxt);
        const char* nA = has_next ? (const char*)g.A + (size_t)nxt.pm * tstep : cA; const char* nB = has_next ? (const char*)g.Bt + (size_t)nxt.pn * tstep : cB;
        for (int t = 0; t < nt; t += 2) {
            if constexpr (Epi::MID_T > 0) { if (t == Epi::MID_T) E.mid(acc, ui, wr, fr); }
            const bool last = (t == nt - 2);
            const char* a1 = cA + (size_t)(t + 1) * kstep;
            const char* a2 = last ? nA : cA + (size_t)(t + 2) * kstep; const char* b2 = last ? nB : cB + (size_t)(t + 2) * kstep;
            const char* a3 = a2 + kstep; const char* b3 = b2 + kstep;
            if (last && has_next) S.a_ready(nxt);
            if constexpr (SP2) {
            PG8_LDB(B0, 0, 0); PG8_LDB(B1, 0, 1); PG8_SCHED; PG8_LDA(At, 0, 0); PG8_STAGE(PG8_SA(1, 1), a1 + hstep, voffA);
            PG8_WAIT_V(8); PG8_WAIT_L(0); PG8_BAR; PG8_MMA(0, 0, At, B0); PG8_MMA(0, 1, At, B1); PG8_BAR; PG8_SCHED;
            PG8_LDA(At, 0, 1); PG8_STAGE(PG8_SB(0, 0), b2, voffB); PG8_STAGE(PG8_SB(0, 1), b2 + hstep, voffB); PG8_STAGE(PG8_SA(0, 0), a2, voffA);
            PG8_WAIT_V(8); PG8_WAIT_L(0); PG8_BAR; PG8_MMA(1, 0, At, B0); PG8_MMA(1, 1, At, B1); PG8_BAR; PG8_SCHED;
            PG8_LDB(B0, 1, 0); PG8_LDB(B1, 1, 1); PG8_SCHED; PG8_LDA(At, 1, 0); PG8_STAGE(PG8_SA(0, 1), a2 + hstep, voffA);
            PG8_WAIT_V(8); PG8_WAIT_L(0); PG8_BAR; PG8_MMA(0, 0, At, B0); PG8_MMA(0, 1, At, B1); PG8_BAR; PG8_SCHED;
            PG8_LDA(At, 1, 1); PG8_STAGE(PG8_SB(1, 0), b3, voffB); PG8_STAGE(PG8_SB(1, 1), b3 + hstep, voffB); PG8_STAGE(PG8_SA(1, 0), a3, voffA);
            PG8_WAIT_V(8); PG8_WAIT_L(0); PG8_BAR; PG8_MMA(1, 0, At, B0); PG8_MMA(1, 1, At, B1); PG8_BAR; PG8_SCHED;
            } else {
            PG8_LDB(B0, 0, 0); PG8_SCHED; PG8_LDA(At, 0, 0); PG8_STAGE(PG8_SA(1, 1), a1 + hstep, voffA);
            PG8_WAIT_L(8); PG8_BAR; PG8_WAIT_L(0); PG8_MMA(0, 0, At, B0); PG8_BAR; PG8_SCHED;
            PG8_LDB(B1, 0, 1); PG8_STAGE(PG8_SB(0, 0), b2, voffB);
            PG8_BAR; PG8_WAIT_L(0); PG8_MMA(0, 1, At, B1); PG8_BAR;
            PG8_LDA(At, 0, 1); PG8_STAGE(PG8_SA(0, 0), a2, voffA);
            PG8_BAR; PG8_WAIT_L(0); PG8_MMA(1, 0, At, B0); PG8_BAR; PG8_SCHED;
            PG8_STAGE(PG8_SB(0, 1), b2 + hstep, voffB);
            PG8_WAIT_V(6); PG8_BAR; PG8_MMA(1, 1, At, B1); PG8_BAR;
            PG8_LDB(B0, 1, 0); PG8_SCHED; PG8_LDA(At, 1, 0); PG8_STAGE(PG8_SA(0, 1), a2 + hstep, voffA);
            PG8_WAIT_L(8); PG8_BAR; PG8_WAIT_L(0); PG8_MMA(0, 0, At, B0); PG8_BAR; PG8_SCHED;
            PG8_LDB(B1, 1, 1); PG8_STAGE(PG8_SB(1, 0), b3, voffB);
            PG8_BAR; PG8_WAIT_L(0); PG8_MMA(0, 1, At, B1); PG8_BAR;
            PG8_LDA(At, 1, 1); PG8_STAGE(PG8_SA(1, 0), a3, voffA);
            PG8_BAR; PG8_WAIT_L(0); PG8_MMA(1, 0, At, B0); PG8_BAR; PG8_SCHED;
            PG8_STAGE(PG8_SB(1, 1), b3 + hstep, voffB);
            PG8_WAIT_V(6); PG8_BAR; PG8_MMA(1, 1, At, B1); PG8_BAR;
            }
        }
        if constexpr (ALIGN_EPI) { if (wr == 0) PG8_BAR; }
        if constexpr (!Epi::AFTER_DRAIN) { E(acc, cur, ui, wr, wc, fr, fq); S.done(cur); }
        if (!has_next) break;
#pragma unroll
        for (int a = 0; a < 2; ++a)
#pragma unroll
            for (int b = 0; b < 2; ++b)
#pragma unroll
                for (int m = 0; m < 4; ++m)
#pragma unroll
                    for (int n = 0; n < 2; ++n) acc[a][b][m][n] = (f32x4){0.f, 0.f, 0.f, 0.f};
        cur = nxt; cA = nA; cB = nB; ++ui;
        if constexpr (ALIGN_EPI) { if (wr == 1) PG8_BAR; }
    }
    PG8_WAIT_V(0);
    if constexpr (!ALIGN_EPI) { if (wr == 0) PG8_BAR; }
    PG8_BAR;
    if constexpr (Epi::AFTER_DRAIN) { E.fused(acc, cur, wr, wc, fr, fq, lds, wid, lane); S.done(cur); }
#undef PG8_SA
#undef PG8_SB
#undef PG8_STAGE
#undef PG8_LDA
#undef PG8_LDB
#undef PG8_MMA
#undef PG8_WAIT_V
#undef PG8_WAIT_L
#undef PG8_BAR
#undef PG8_SCHED
}
}
#define GAS __attribute__((address_space(1)))
#define LAS __attribute__((address_space(3)))
typedef unsigned short bf16;
typedef unsigned v4u __attribute__((ext_vector_type(4)));
typedef float f32x4 __attribute__((ext_vector_type(4)));
typedef short bf16x8 __attribute__((ext_vector_type(8)));
typedef GAS unsigned gu32;
typedef GAS unsigned long long gu64;
#define RLX_AGENT __ATOMIC_RELAXED, __HIP_MEMORY_SCOPE_AGENT
#define LDS_WAIT() asm volatile("s_waitcnt lgkmcnt(0)" ::: "memory")
#define VM_WAIT() asm volatile("s_waitcnt vmcnt(0)" ::: "memory")
__device__ __forceinline__ unsigned long long rt() { return __builtin_amdgcn_s_memrealtime(); }
__device__ __forceinline__ unsigned f2bf(float f) { unsigned u = __builtin_bit_cast(unsigned, f); return (u + 0x7fffu + ((u >> 16) & 1u)) >> 16; }
__device__ __forceinline__ unsigned pk2(float lo, float hi) { return f2bf(lo) | (f2bf(hi) << 16); }

#define XB_TMO      128
#define XB_XCNT(j)  (256  + 64 * (j))
#define XB_XSUB(j)  (1280 + 64 * (j))
#define XB_XGEN(j)  (2304 + 64 * (j))
#define XB_TOP      3328
#define XB_TOPGEN   3392
#define XCD_BAR_WORDS 3456
#define XB_SPIN_CAP (1u << 18)

__device__ __forceinline__ unsigned xb_ld(unsigned* p)              { return __hip_atomic_load(p, __ATOMIC_RELAXED, __HIP_MEMORY_SCOPE_AGENT); }
__device__ __forceinline__ unsigned xb_add(unsigned* p, unsigned v) { return __hip_atomic_fetch_add(p, v, __ATOMIC_RELAXED, __HIP_MEMORY_SCOPE_AGENT); }
__device__ __forceinline__ unsigned xb_xcc_id() { return (unsigned)__builtin_amdgcn_s_getreg((3 << 11) | 20) & 0xFu; }
#define XB_SPIN(cond, bar) do { unsigned _sp = 0; while (cond) { __builtin_amdgcn_s_sleep(1); \
    if ((++_sp & 255u) == 0u) { if (xb_ld(&(bar)[XB_TMO])) break; if (_sp > XB_SPIN_CAP) { atomicAdd(&(bar)[XB_TMO], 1u); break; } } } } while (0)

struct XcdBarrier {
    unsigned* bar; unsigned x;
    volatile LAS unsigned* st;
};

__device__ __forceinline__ XcdBarrier xcd_barrier_post(unsigned* bar, volatile LAS unsigned* st) {
    XcdBarrier b; b.bar = bar; b.x = xb_xcc_id(); b.st = st;
    if (threadIdx.x == 0) (void)xb_add(&bar[XB_XCNT(b.x)], 1u);
    return b;
}
__device__ __forceinline__ void xcd_barrier_complete(unsigned* bar, unsigned x, unsigned& nloc, unsigned& nx) {
    const unsigned G = XB_NPART;
    unsigned sum, cnt, mine, sp = 0u;
    for (;;) {
        sum = 0u; cnt = 0u; mine = 0u;
#pragma unroll
        for (unsigned j = 0; j < 16; ++j) { const unsigned c = xb_ld(&bar[XB_XCNT(j)]); sum += c; cnt += (c > 0u) ? 1u : 0u; mine = (j == x) ? c : mine; }
        if (sum == G) break;
        __builtin_amdgcn_s_sleep(1);
        if ((++sp & 255u) == 0u) { if (xb_ld(&bar[XB_TMO])) break; if (sp > XB_SPIN_CAP) { atomicAdd(&bar[XB_TMO], 1u); break; } }
    }
    nloc = mine > 0u ? mine : 1u; nx = cnt > 0u ? cnt : 1u;
}

__device__ __forceinline__ void xcd_barrier(const XcdBarrier& b) {
    asm volatile("s_waitcnt vmcnt(0)" ::: "memory");
    __syncthreads();
    if (threadIdx.x == 0) {
        unsigned* bar = b.bar;
        __builtin_amdgcn_s_waitcnt(0);
        unsigned nloc = b.st[0], nx = b.st[1];
        if (nloc == 0u) { xcd_barrier_complete(bar, b.x, nloc, nx); b.st[0] = nloc; b.st[1] = nx; }
        const unsigned old = xb_add(&bar[XB_XSUB(b.x)], 1u);
        const unsigned gen = old / nloc;
        if (old + 1u == (gen + 1u) * nloc) {
            __builtin_amdgcn_fence(__ATOMIC_RELEASE, "agent");
            asm volatile("s_waitcnt vmcnt(0)" ::: "memory");
            const unsigned og = xb_add(&bar[XB_TOP], 1u);
            const unsigned tg = og / nx;
            if (og + 1u == (tg + 1u) * nx) xb_add(&bar[XB_TOPGEN], 1u);
            else XB_SPIN(xb_ld(&bar[XB_TOPGEN]) == tg, bar);
            __builtin_amdgcn_fence(__ATOMIC_ACQUIRE, "agent");
            xb_add(&bar[XB_XGEN(b.x)], 1u);
            asm volatile("s_waitcnt vmcnt(0)" ::: "memory");
        } else {
            XB_SPIN(xb_ld(&bar[XB_XGEN(b.x)]) == gen, bar);
            __builtin_amdgcn_fence(__ATOMIC_ACQUIRE, "agent");
            asm volatile("s_waitcnt vmcnt(0)" ::: "memory");
        }
    }
    __syncthreads();
}


constexpr size_t MiB = 1u << 20;
constexpr size_t WS_CTL = 0, CTL_ZERO_BYTES = 1 * MiB;
constexpr size_t WS_MOD = 1 * MiB;
constexpr size_t WS_COS = 5 * MiB, WS_SIN = 7 * MiB;
constexpr size_t WS_SSQ = 9 * MiB;
constexpr size_t WS_WIN = 12 * MiB, WS_WO = 17 * MiB, WS_WGU = 20 * MiB, WS_WD = 32 * MiB;
constexpr size_t WS_XN = 40 * MiB;
constexpr size_t WS_QKV = 76 * MiB;
constexpr size_t WS_OB = 152 * MiB;
constexpr size_t WS_X1 = 186 * MiB;
constexpr size_t WS_HM = 256 * MiB;
constexpr size_t WS_X2 = 348 * MiB;
constexpr size_t WS_END = 382 * MiB;
static_assert(WS_MOD + (size_t)NMB * NMOD * 4 <= WS_COS && WS_COS + (size_t)NPOS * 32 * 4 <= WS_SIN && WS_SIN + (size_t)NPOS * 32 * 4 <= WS_SSQ && WS_SSQ + (size_t)MT * 16 * 4 <= WS_WIN, "ws map 1");
static_assert(WS_WIN + (size_t)INC * D * 2 <= WS_WO && WS_WO + (size_t)D * D * 2 <= WS_WGU && WS_WGU + (size_t)2 * FF * D * 2 <= WS_WD && WS_WD + (size_t)D * FF * 2 <= WS_XN, "ws map 2");
static_assert(WS_XN + (size_t)MT * D * 2 <= WS_QKV && WS_QKV + (size_t)MT * INC * 2 <= WS_OB && WS_OB + (size_t)MT * D * 2 <= WS_X1 && WS_X1 + (size_t)MT * D * 4 <= WS_HM && WS_HM + (size_t)MT * FF * 2 <= WS_X2 && WS_X2 + (size_t)MT * D * 2 <= WS_END, "ws map 3");
constexpr int CW_TMO = 0, CW_COPY_HEAD = 64, CW_ATT_HEAD = 128, CW_PAUSE = 192, CW_SETUP = 256, CW_P5_HEAD = 320, CW_P8_HEAD = 384, CW_ATTQ = 1024, CW_BAR = 4096, CW_PANEL4 = 8192, CW_PANEL7 = 16384;

constexpr int RING_OFF = 0, RING_BYTES = 131072;
constexpr int LDSCTL_OFF = RING_BYTES, MISC_OFF = LDSCTL_OFF + 320, TAB_OFF = LDSCTL_OFF + 1024;
constexpr int LDS_BYTES = 147456;
static_assert(TAB_OFF + 4096 <= LDS_BYTES, "LDS map");
constexpr int NWAVES = 8, NTHREADS = NWAVES * 64;

typedef float f32x16 __attribute__((ext_vector_type(16)));
typedef short s16x4 __attribute__((ext_vector_type(4)));
typedef short v4i16_t __attribute__((ext_vector_type(4)));
typedef unsigned u32x2 __attribute__((ext_vector_type(2)));
typedef float f32x2 __attribute__((ext_vector_type(2)));

__device__ __forceinline__ float bf2f(unsigned h) { return __uint_as_float(h << 16); }
__device__ __forceinline__ unsigned cvtpk(float lo, float hi) { unsigned r; asm("v_cvt_pk_bf16_f32 %0, %1, %2" : "=v"(r) : "v"(lo), "v"(hi)); return r; }
__device__ __forceinline__ float wave_sum(float v) {
#pragma unroll
    for (int o = 1; o < 64; o <<= 1) v += __shfl_xor(v, o);
    return v;
}
__device__ __forceinline__ float ex2(float x) { return __builtin_amdgcn_exp2f(x); }
#define DPP_F(v, ctrl) __builtin_bit_cast(float, __builtin_amdgcn_update_dpp(0, __builtin_bit_cast(int, (v)), (ctrl), 0xf, 0xf, false))
__device__ __forceinline__ float sum16(float v) { v += DPP_F(v, 0xB1); v += DPP_F(v, 0x4E); v += DPP_F(v, 0x141); v += DPP_F(v, 0x140); return v; }
__device__ __forceinline__ void swap32(float& a, float& b) { asm volatile("s_nop 1\n\tv_permlane32_swap_b32 %0, %1\n\ts_nop 1" : "+v"(a), "+v"(b)); }
__device__ __forceinline__ float xmax32(float v) { float a = v, b = v; swap32(a, b); return fmaxf(a, b); }
__device__ __forceinline__ float xsum32(float v) { float a = v, b = v; swap32(a, b); return a + b; }

__device__ __forceinline__ void split8(const float (&v)[8], bf16x8& hi, bf16x8& lo) {
#pragma unroll
    for (int i = 0; i < 8; ++i) { const unsigned h = f2bf(v[i]); hi[i] = (short)h; lo[i] = (short)f2bf(v[i] - bf2f(h)); }
}
__device__ __forceinline__ float silu_f(float x) { return x / (1.0f + ex2(-LOG2E * x)); }
__device__ __forceinline__ void ada_block(LAS unsigned char* lds, int ct, const float* cp, const float* cs, const float* w_ada, const float* b_ada, float* mod, int tid, int wave, int lane) {
    const int n0 = 32 * ct, ln = lane & 31, hi = lane >> 5;
    f32x16 acc[5];
#pragma unroll
    for (int rt = 0; rt < 5; ++rt)
#pragma unroll
        for (int r = 0; r < 16; ++r) acc[rt][r] = 0.f;
#pragma unroll 1
    for (int ks = 0; ks < 8; ++ks) {
        const int kb = 128 * wave + 16 * ks + 8 * hi;
        float bv[8];
#pragma unroll
        for (int i = 0; i < 8; ++i) bv[i] = __builtin_nontemporal_load(w_ada + (size_t)(kb + i) * NMOD + n0 + ln);
        bf16x8 bh, bl; split8(bv, bh, bl);
#pragma unroll
        for (int rt = 0; rt < 5; ++rt) {
            const int row = 32 * rt + ln;
            float av[8];
            if (row < NMB) { const float* c = (row < NB ? cp + (size_t)row * D : cs + (size_t)(row - NB) * D) + kb;
                const f32x4 c0 = *(const f32x4*)c, c1 = *(const f32x4*)(c + 4);
                av[0] = silu_f(c0[0]); av[1] = silu_f(c0[1]); av[2] = silu_f(c0[2]); av[3] = silu_f(c0[3]); av[4] = silu_f(c1[0]); av[5] = silu_f(c1[1]); av[6] = silu_f(c1[2]); av[7] = silu_f(c1[3]);
            } else {
#pragma unroll
                for (int i = 0; i < 8; ++i) av[i] = 0.f;
            }
            bf16x8 ah, al; split8(av, ah, al);
            acc[rt] = __builtin_amdgcn_mfma_f32_32x32x16_bf16(ah, bh, acc[rt], 0, 0, 0);
            acc[rt] = __builtin_amdgcn_mfma_f32_32x32x16_bf16(ah, bl, acc[rt], 0, 0, 0);
            acc[rt] = __builtin_amdgcn_mfma_f32_32x32x16_bf16(al, bh, acc[rt], 0, 0, 0);
        }
    }
    LAS float* red = (LAS float*)lds;
#pragma unroll
    for (int rt = 0; rt < 5; ++rt) {
#pragma unroll
        for (int r = 0; r < 16; ++r) red[(wave * 16 + r) * 64 + lane] = acc[rt][r];
        __syncthreads();
#pragma unroll
        for (int x = 0; x < 2; ++x) { const int e = tid + 512 * x, r = e >> 6, l2 = e & 63; float s = 0.f;
#pragma unroll
            for (int w = 0; w < 8; ++w) s += red[(w * 16 + r) * 64 + l2];
            const int mrow = 32 * rt + (r & 3) + 8 * (r >> 2) + 4 * (l2 >> 5), col = n0 + (l2 & 31);
            if (mrow < NMB) mod[(size_t)mrow * NMOD + col] = s + b_ada[col]; }
        __syncthreads();
    }
}

template <class RowMap>
__device__ __forceinline__ void tr_load(float (&v)[32], const float* W, int N, const float* sc_a, const float* sc_b, int item, int lane) {
    const int nblk = N / 32, kb = item / nblk, nb = item % nblk, k0 = 64 * kb, n0 = 32 * nb;
#pragma unroll
    for (int i = 0; i < 32; ++i) { const int kk = 2 * i + (lane >> 5); v[i] = __builtin_nontemporal_load(W + (size_t)(k0 + kk) * N + n0 + (lane & 31));
        if (sc_a) { const int k = k0 + kk; v[i] *= (k < 512 ? sc_a[k] : sc_b[k - 512]); } }
}
template <class RowMap>
__device__ __forceinline__ void tr_store(const float (&v)[32], int K, int N, bf16* WT, RowMap rm, LAS float* scr, int item, int lane) {
    const int nblk = N / 32, kb = item / nblk, nb = item % nblk, k0 = 64 * kb, n0 = 32 * nb;
#pragma unroll
    for (int i = 0; i < 32; ++i) scr[(2 * i + (lane >> 5)) * 33 + (lane & 31)] = v[i];
    LDS_WAIT(); asm volatile("" ::: "memory");
    const int c = lane & 7;
#pragma unroll
    for (int j = 0; j < 4; ++j) { const int n = (lane >> 3) + 8 * j; const LAS float* s = scr + (8 * c) * 33 + n;
        v4u o; o.x = cvtpk(s[0 * 33], s[1 * 33]); o.y = cvtpk(s[2 * 33], s[3 * 33]); o.z = cvtpk(s[4 * 33], s[5 * 33]); o.w = cvtpk(s[6 * 33], s[7 * 33]);
        *(GAS v4u*)(WT + (size_t)rm(n0 + n) * K + k0 + 8 * c) = o; }
    LDS_WAIT(); asm volatile("" ::: "memory");
}
template <class RowMap>
__device__ __forceinline__ void transpose_matrix(const float* W, int K, int N, bf16* WT, RowMap rm, const float* sc_a, const float* sc_b, LAS float* scr, int first, int stride, int nitems, int lane) {
    for (int it = first; it < nitems; it += 2 * stride) {
        float va[32], vb[32]; const int it2 = it + stride; const bool two = it2 < nitems;
        tr_load<RowMap>(va, W, N, sc_a, sc_b, it, lane);
        if (two) tr_load<RowMap>(vb, W, N, sc_a, sc_b, it2, lane);
        tr_store<RowMap>(va, K, N, WT, rm, scr, it, lane);
        if (two) tr_store<RowMap>(vb, K, N, WT, rm, scr, it2, lane);
    }
}
struct RmIn { __device__ __forceinline__ int operator()(int n) const { const int h64 = n >> 6, e = n & 63; const bool rot = h64 < 10 || (h64 >= 12 && h64 < 28);
    return rot ? (n & ~63) + 8 * ((e & 31) >> 2) + (e & 3) + 4 * (e >> 5) : n; } };
struct RmId { __device__ __forceinline__ int operator()(int n) const { return n; } };
struct RmGate { __device__ __forceinline__ int operator()(int n) const { return 256 * (n >> 7) + (n & 127); } };
struct RmUp { __device__ __forceinline__ int operator()(int n) const { return 256 * (n >> 7) + 128 + (n & 127); } };

__device__ __forceinline__ void rope_entry(int e, float* COS, float* SIN) {
    const int pos = e >> 5, i = e & 31;
    double inv = 1.0; for (int k = 0; k < i; ++k) inv *= 0.74989420933245582730;
    const double rev = (double)pos * inv * 0.15915494309189533577;
    const double fr = rev - __builtin_rint(rev);
    const double qd = __builtin_rint(fr * 4.0);
    const double z = (fr - qd * 0.25) * 6.28318530717958647693, z2 = z * z;
    const double s = z * (1.0 + z2 * (-1.0 / 6 + z2 * (1.0 / 120 + z2 * (-1.0 / 5040 + z2 * (1.0 / 362880 + z2 * (-1.0 / 39916800 + z2 * (1.0 / 6227020800.0)))))));
    const double c = 1.0 + z2 * (-0.5 + z2 * (1.0 / 24 + z2 * (-1.0 / 720 + z2 * (1.0 / 40320 + z2 * (-1.0 / 3628800 + z2 * (1.0 / 479001600.0))))));
    const int q = ((int)qd) & 3;
    const double sn = q == 0 ? s : q == 1 ? c : q == 2 ? -s : -c;
    const double cs = q == 0 ? c : q == 1 ? -s : q == 2 ? -c : s;
    COS[e] = (float)cs; SIN[e] = (float)sn;
}

__device__ __forceinline__ void normmod_row(const float* xrow, const float* g, const float* sh, const float* sc, bf16* orow, int lane) {
    const GAS f32x4* xr = (const GAS f32x4*)xrow + lane;
    f32x4 v[4]; float s = 0.f;
#pragma unroll
    for (int j = 0; j < 4; ++j) { v[j] = __builtin_nontemporal_load(xr + 64 * j); s += (v[j].x * v[j].x + v[j].y * v[j].y) + (v[j].z * v[j].z + v[j].w * v[j].w); }
    const float rstd = 1.f / sqrtf(wave_sum(s) * (1.f / D) + EPS);
    GAS unsigned long long* o8 = (GAS unsigned long long*)orow + lane;
#pragma unroll
    for (int j = 0; j < 4; ++j) { const f32x4 gg = ((const GAS f32x4*)g)[lane + 64 * j], hh = ((const GAS f32x4*)sh)[lane + 64 * j], cc = ((const GAS f32x4*)sc)[lane + 64 * j];
        const f32x4 o = v[j] * rstd * gg * (cc + 1.0f) + hh;
        o8[64 * j] = (unsigned long long)cvtpk(o.x, o.y) | ((unsigned long long)cvtpk(o.z, o.w) << 32); }
}
__device__ __forceinline__ void normmod_row_bf16(const bf16* xrow, const float* g, const float* sh, const float* sc, bf16* orow, int lane) {
    const GAS u32x2* xr = (const GAS u32x2*)xrow + lane;
    f32x4 v[4]; float s = 0.f;
#pragma unroll
    for (int j = 0; j < 4; ++j) { const u32x2 w = xr[64 * j]; v[j] = (f32x4){bf2f(w.x & 0xffffu), bf2f(w.x >> 16), bf2f(w.y & 0xffffu), bf2f(w.y >> 16)};
        s += (v[j].x * v[j].x + v[j].y * v[j].y) + (v[j].z * v[j].z + v[j].w * v[j].w); }
    const float rstd = 1.f / sqrtf(wave_sum(s) * (1.f / D) + EPS);
    GAS unsigned long long* o8 = (GAS unsigned long long*)orow + lane;
#pragma unroll
    for (int j = 0; j < 4; ++j) { const f32x4 gg = ((const GAS f32x4*)g)[lane + 64 * j], hh = ((const GAS f32x4*)sh)[lane + 64 * j], cc = ((const GAS f32x4*)sc)[lane + 64 * j];
        const f32x4 o = v[j] * rstd * gg * (cc + 1.0f) + hh;
        o8[64 * j] = (unsigned long long)cvtpk(o.x, o.y) | ((unsigned long long)cvtpk(o.z, o.w) << 32); }
}
__device__ __forceinline__ void resid_normmod_row(const float* xrow, bf16* trow, const float* g, const float* sh, const float* sc, bf16* orow, int lane) {
    const GAS f32x4* xr = (const GAS f32x4*)xrow + lane; GAS u32x2* tr = (GAS u32x2*)trow + lane;
    f32x4 v[4]; float s = 0.f;
#pragma unroll
    for (int j = 0; j < 4; ++j) { const u32x2 w = tr[64 * j]; v[j] = __builtin_nontemporal_load(xr + 64 * j) + (f32x4){bf2f(w.x & 0xffffu), bf2f(w.x >> 16), bf2f(w.y & 0xffffu), bf2f(w.y >> 16)};
        s += (v[j].x * v[j].x + v[j].y * v[j].y) + (v[j].z * v[j].z + v[j].w * v[j].w);
        u32x2 o; o.x = cvtpk(v[j].x, v[j].y); o.y = cvtpk(v[j].z, v[j].w); tr[64 * j] = o; }
    const float rstd = 1.f / sqrtf(wave_sum(s) * (1.f / D) + EPS);
    GAS unsigned long long* o8 = (GAS unsigned long long*)orow + lane;
#pragma unroll
    for (int j = 0; j < 4; ++j) { const f32x4 gg = ((const GAS f32x4*)g)[lane + 64 * j], hh = ((const GAS f32x4*)sh)[lane + 64 * j], cc = ((const GAS f32x4*)sc)[lane + 64 * j];
        const f32x4 o = v[j] * rstd * gg * (cc + 1.0f) + hh;
        o8[64 * j] = (unsigned long long)cvtpk(o.x, o.y) | ((unsigned long long)cvtpk(o.z, o.w) << 32); }
}
__device__ __forceinline__ void final_row(const bf16* xrow, float* yrow, const float* g, int lane) {
    const GAS u32x2* xr = (const GAS u32x2*)xrow + lane;
    f32x4 v[4]; float s = 0.f;
#pragma unroll
    for (int j = 0; j < 4; ++j) { const u32x2 w = xr[64 * j]; v[j] = (f32x4){bf2f(w.x & 0xffffu), bf2f(w.x >> 16), bf2f(w.y & 0xffffu), bf2f(w.y >> 16)};
        s += (v[j].x * v[j].x + v[j].y * v[j].y) + (v[j].z * v[j].z + v[j].w * v[j].w); }
    const float rstd = 1.f / sqrtf(wave_sum(s) * (1.f / D) + EPS);
    GAS f32x4* yr = (GAS f32x4*)yrow + lane;
#pragma unroll
    for (int j = 0; j < 4; ++j) __builtin_nontemporal_store(v[j] * rstd * ((const GAS f32x4*)g)[lane + 64 * j], yr + 64 * j);
}

__device__ __forceinline__ s16x4 vtr(const LAS unsigned char* p) { return __builtin_bit_cast(s16x4, __builtin_amdgcn_ds_read_tr16_b64_v4i16((LAS v4i16_t*)p)); }

template <bool SINK>
__device__ __forceinline__ void attn_wave_tile(const bf16* __restrict__ QKV, int rowbase, int dil, int r, int m0, int qcol, int kcol, int vcol, float sink2, LAS unsigned char* vst, int lane,
                                               float& m_out, float& l_out, f32x16& o0, f32x16& o1) {
    constexpr int MAXD = SINK ? WA - 1 : 128;
    const int i = lane & 31, hi = lane >> 5;
    const int nkt = (m0 >> 5) + 1 < 5 ? (m0 >> 5) + 1 : 5;
    bf16x8 qf[4], kf[5][4]; v4u vv[3][4];
    { const bf16* qp = QKV + (size_t)(rowbase + (m0 + i) * dil + r) * INC + qcol + 32 * hi;
#pragma unroll
      for (int s = 0; s < 4; ++s) qf[s] = *(const bf16x8*)(qp + 8 * s); }
#pragma unroll
    for (int step = 0; step < 5; ++step) {
        const int mk0 = m0 - (step < nkt ? 32 * step : 0);
        const bf16* kp = QKV + (size_t)(rowbase + (mk0 + i) * dil + r) * INC + kcol + 32 * hi;
#pragma unroll
        for (int s = 0; s < 4; ++s) kf[step][s] = *(const bf16x8*)(kp + 8 * s);
        if (step < 3) {
#pragma unroll
        for (int it = 0; it < 4; ++it) vv[step][it] = *(const v4u*)(QKV + (size_t)(rowbase + (mk0 + (lane >> 3) + 8 * it) * dil + r) * INC + vcol + 8 * (lane & 7)); }
    }
    float mrun = SINK ? sink2 : -INFINITY, lrun = SINK ? (hi == 0 ? 1.f : 0.f) : 0.f;
#pragma unroll
    for (int x = 0; x < 16; ++x) { o0[x] = 0.f; o1[x] = 0.f; }
    const int tr_off = (4 * hi + ((lane & 15) >> 2)) * 128 + (16 * ((lane >> 4) & 1) + 4 * (lane & 3)) * 2;
#pragma unroll
    for (int step = 0; step < 5; ++step) {
        if (step < nkt) {
        const int kt = 4 - step;
        f32x16 s;
#pragma unroll
        for (int x = 0; x < 16; ++x) s[x] = 0.f;
#pragma unroll
        for (int ss = 0; ss < 4; ++ss) s = __builtin_amdgcn_mfma_f32_32x32x16_bf16(kf[step][ss], qf[ss], s, 0, 0, 0);
        asm volatile("" ::: "memory");
#pragma unroll
        for (int it = 0; it < 4; ++it) *(LAS v4u*)(vst + ((lane >> 3) + 8 * it) * 128 + (lane & 7) * 16) = vv[step % 3][it];
        if (step < 2) { const int mk3 = m0 - (step + 3 < nkt ? 32 * (step + 3) : 0);
#pragma unroll
            for (int it = 0; it < 4; ++it) vv[step][it] = *(const v4u*)(QKV + (size_t)(rowbase + (mk3 + (lane >> 3) + 8 * it) * dil + r) * INC + vcol + 8 * (lane & 7)); }
        asm volatile("s_waitcnt lgkmcnt(0)" ::: "memory");
        if (kt == 4 || kt == 0) {
            const int dbase = 128 - 32 * kt + i;
#pragma unroll
            for (int x = 0; x < 16; ++x) { const int j = (x & 3) + 8 * (x >> 2) + 4 * hi; const int dist = dbase - j;
                s[x] = (dist >= 0 && dist <= MAXD) ? s[x] : -INFINITY; }
        }
        float mx = s[0];
#pragma unroll
        for (int x = 1; x < 16; ++x) mx = fmaxf(mx, s[x]);
        mx = xmax32(mx);
        const float mn = fmaxf(mrun, mx);
        const float corr = ex2(mrun - mn);
        float ps = 0.f;
#pragma unroll
        for (int x = 0; x < 16; ++x) { s[x] = ex2(s[x] - mn); ps += s[x]; }
        lrun = lrun * corr + ps; mrun = mn;
        o0 = o0 * corr; o1 = o1 * corr;
        v4u p0u, p1u;
        p0u.x = cvtpk(s[0], s[1]); p0u.y = cvtpk(s[2], s[3]); p0u.z = cvtpk(s[4], s[5]); p0u.w = cvtpk(s[6], s[7]);
        p1u.x = cvtpk(s[8], s[9]); p1u.y = cvtpk(s[10], s[11]); p1u.z = cvtpk(s[12], s[13]); p1u.w = cvtpk(s[14], s[15]);
        const bf16x8 pa0 = __builtin_bit_cast(bf16x8, p0u), pa1 = __builtin_bit_cast(bf16x8, p1u);
#pragma unroll
        for (int dt = 0; dt < 2; ++dt) {
#pragma unroll
            for (int j = 0; j < 2; ++j) {
                const LAS unsigned char* a = vst + tr_off + j * 16 * 128 + dt * 64;
                const s16x4 lo = vtr(a), hh = vtr(a + 8 * 128);
                const bf16x8 vf = (bf16x8){lo[0], lo[1], lo[2], lo[3], hh[0], hh[1], hh[2], hh[3]};
                if (dt == 0) o0 = __builtin_amdgcn_mfma_f32_32x32x16_bf16(vf, j == 0 ? pa0 : pa1, o0, 0, 0, 0);
                else         o1 = __builtin_amdgcn_mfma_f32_32x32x16_bf16(vf, j == 0 ? pa0 : pa1, o1, 0, 0, 0);
            }
        }
        asm volatile("" ::: "memory");
        }
    }
    l_out = xsum32(lrun); m_out = mrun;
}

__device__ __forceinline__ void finalize_store(const f32x16& o0, const f32x16& o1, float l, bf16* orow, float* ssqp, int hi) {
    const float inv = 1.0f / l; float ss = 0.f;
#pragma unroll
    for (int dt = 0; dt < 2; ++dt)
#pragma unroll
        for (int gq = 0; gq < 4; ++gq) {
            const float a = (dt == 0 ? o0[4 * gq] : o1[4 * gq]) * inv, b = (dt == 0 ? o0[4 * gq + 1] : o1[4 * gq + 1]) * inv, c = (dt == 0 ? o0[4 * gq + 2] : o1[4 * gq + 2]) * inv, d = (dt == 0 ? o0[4 * gq + 3] : o1[4 * gq + 3]) * inv;
            ss += (a * a + b * b) + (c * c + d * d);
            u32x2 w; w.x = pk2(a, b); w.y = pk2(c, d);
            *(u32x2*)(orow + 32 * dt + 8 * gq + 4 * hi) = w; }
    ss = xsum32(ss);
    if (hi == 0) *ssqp = ss;
}

struct SSt { float m, l; f32x4 o; };
__device__ __forceinline__ void s_step(SSt& st, const f32x4& q4, const f32x4& k4, const f32x4& v4, bool valid) {
    float s = (q4.x * k4.x + q4.y * k4.y) + (q4.z * k4.z + q4.w * k4.w);
    s = sum16(s);
    s = valid ? s : -INFINITY;
    const float mn = fmaxf(st.m, s);
    const float corr = (mn == -INFINITY) ? 1.f : ex2(st.m - mn);
    const float p = valid ? ex2(s - mn) : 0.f;
    st.l = st.l * corr + p; st.o = st.o * corr + v4 * p; st.m = mn;
}
__device__ __forceinline__ void s_merge(SSt& st) {
#pragma unroll
    for (int x = 16; x <= 32; x <<= 1) {
        const float m2 = __shfl_xor(st.m, x), l2 = __shfl_xor(st.l, x);
        f32x4 o2; o2.x = __shfl_xor(st.o.x, x); o2.y = __shfl_xor(st.o.y, x); o2.z = __shfl_xor(st.o.z, x); o2.w = __shfl_xor(st.o.w, x);
        const float mn = fmaxf(st.m, m2);
        const float a = (st.m == -INFINITY) ? 0.f : ex2(st.m - mn), b = (m2 == -INFINITY) ? 0.f : ex2(m2 - mn);
        st.l = st.l * a + l2 * b; st.o = st.o * a + o2 * b; st.m = mn;
    }
}
__device__ __forceinline__ f32x4 load_q4(const bf16* QKV, int row, int qcol, int c) {
    const u32x2 w = *(const u32x2*)(QKV + (size_t)row * INC + qcol + 8 * (c & 7) + 4 * (c >> 3));
    f32x4 q; q.x = bf2f(w.x & 0xffffu); q.y = bf2f(w.x >> 16); q.z = bf2f(w.y & 0xffffu); q.w = bf2f(w.y >> 16); return q;
}
__device__ __forceinline__ void s_store(const SSt& st, bf16* orow, float* ssqp, int lane) {
    const int c = lane & 15; const float inv = 1.0f / st.l; const f32x4 o = st.o * inv;
    float ss = (o.x * o.x + o.y * o.y) + (o.z * o.z + o.w * o.w);
    ss = sum16(ss);
    if (lane < 16) { u32x2 w; w.x = pk2(o.x, o.y); w.y = pk2(o.z, o.w); *(u32x2*)(orow + 4 * c) = w; }
    if (lane == 0) *ssqp = ss;
}


__device__ __forceinline__ int q_pop(gu32* head, volatile LAS unsigned* slot, int tid) {
    if (tid == 0) *slot = __hip_atomic_fetch_add(head, 1u, RLX_AGENT);
    __syncthreads();
    const int v = (int)*slot;
    __syncthreads();
    return __builtin_amdgcn_readfirstlane(v);
}

constexpr int SUB_F4 = 512, SUB_PER_REG = (WB - DS) * 512 / 4 / SUB_F4, NSUBS = 2 * DB * SUB_PER_REG, RANGE = 16, NRANGES = NSUBS / RANGE;
static_assert(SUB_PER_REG == 511 && NSUBS % (8 * RANGE) == 0, "copy chunking");
__device__ __forceinline__ unsigned wave_pop_issue(gu32* head, int lane) { unsigned v = 0u; if (lane == 0) v = __hip_atomic_fetch_add(head, 1u, RLX_AGENT); return v; }
__device__ __forceinline__ void sub_ptrs(int f, const float* cbk, const float* cbv, float* out, int lane, const f32x4*& src, f32x4*& dst) {
    const int reg = f / SUB_PER_REG, sidx = f - reg * SUB_PER_REG, arr = reg >> 7, b = reg & (DB - 1);
    const size_t bo = (size_t)b * WB * 512;
    src = (const f32x4*)((arr ? cbv : cbk) + bo + DS * 512) + sidx * SUB_F4 + lane; dst = (f32x4*)(out + (arr ? O_SBV : O_SBK) + bo) + sidx * SUB_F4 + lane;
}
#define CP_LOAD(buf, f) do { const f32x4* s_; f32x4* d_; sub_ptrs((f), cbk, cbv, out, lane, s_, d_); _Pragma("unroll") for (int k_ = 0; k_ < 8; ++k_) buf[k_] = __builtin_nontemporal_load(s_ + 64 * k_); } while (0)
#define CP_STORE(buf, f) do { const f32x4* s_; f32x4* d_; sub_ptrs((f), cbk, cbv, out, lane, s_, d_); _Pragma("unroll") for (int k_ = 0; k_ < 8; ++k_) __builtin_nontemporal_store(buf[k_], d_ + 64 * k_); } while (0)
__device__ __forceinline__ void copy_drain(gu32* head, gu32* pause, int lane, const float* cbk, const float* cbv, float* out) {
    int c = __builtin_amdgcn_readfirstlane((int)wave_pop_issue(head, lane));
    if (c >= NRANGES) return;
    f32x4 b0[8], b1[8], b2[8], b3[8];
    { const int f0 = (c >> 3) * (8 * RANGE) + (c & 7); CP_LOAD(b0, f0); CP_LOAD(b1, f0 + 8); CP_LOAD(b2, f0 + 16); CP_LOAD(b3, f0 + 24); }
    for (;;) {
        if (pause) { unsigned sp = 0; while (__hip_atomic_load(pause, RLX_AGENT) != 0u && ++sp < (1u << 16)) __builtin_amdgcn_s_sleep(32); }
        const unsigned vnext = wave_pop_issue(head, lane);
        const int f0 = (c >> 3) * (8 * RANGE) + (c & 7);
        CP_STORE(b0, f0 + 0); CP_LOAD(b0, f0 + 32);   CP_STORE(b1, f0 + 8); CP_LOAD(b1, f0 + 40);   CP_STORE(b2, f0 + 16); CP_LOAD(b2, f0 + 48);   CP_STORE(b3, f0 + 24); CP_LOAD(b3, f0 + 56);
        CP_STORE(b0, f0 + 32); CP_LOAD(b0, f0 + 64);   CP_STORE(b1, f0 + 40); CP_LOAD(b1, f0 + 72);   CP_STORE(b2, f0 + 48); CP_LOAD(b2, f0 + 80);  CP_STORE(b3, f0 + 56); CP_LOAD(b3, f0 + 88);
        CP_STORE(b0, f0 + 64); CP_LOAD(b0, f0 + 96);  CP_STORE(b1, f0 + 72); CP_LOAD(b1, f0 + 104);  CP_STORE(b2, f0 + 80); CP_LOAD(b2, f0 + 112); CP_STORE(b3, f0 + 88); CP_LOAD(b3, f0 + 120);
        const int cn = __builtin_amdgcn_readfirstlane((int)vnext);
        if (cn >= NRANGES) { CP_STORE(b0, f0 + 96); CP_STORE(b1, f0 + 104); CP_STORE(b2, f0 + 112); CP_STORE(b3, f0 + 120); break; }
        const int g0 = (cn >> 3) * (8 * RANGE) + (cn & 7);
        CP_STORE(b0, f0 + 96); CP_LOAD(b0, g0 + 0);  CP_STORE(b1, f0 + 104); CP_LOAD(b1, g0 + 8);  CP_STORE(b2, f0 + 112); CP_LOAD(b2, g0 + 16);  CP_STORE(b3, f0 + 120); CP_LOAD(b3, g0 + 24);
        c = cn;
    }
}

__device__ __forceinline__ void unit_A(int unit, const bf16* QKV, const float* sinks, bf16* OB, float* SSQ, LAS unsigned char* vst, int wave, int lane) {
    const int hq = unit & 7, R = (unit >> 3) & 15, b = unit >> 7, i = lane & 31, hi = lane >> 5;
    const float sink2 = sinks[hq] * LOG2E;
#pragma unroll 1
    for (int k = 0; k < 2; ++k) { const int m0 = 512 * R + 32 * (wave + 8 * k);
        float m, l; f32x16 o0, o1;
        attn_wave_tile<true>(QKV, b * SEQ, 1, 0, m0, 64 * hq, 512 + 64 * (hq >> 2), 640 + 64 * (hq >> 2), sink2, vst, lane, m, l, o0, o1);
        const int row = b * SEQ + m0 + i;
        finalize_store(o0, o1, l, OB + (size_t)row * D + 64 * hq, SSQ + (size_t)row * 16 + hq, hi); }
}
__device__ __forceinline__ void unit_B(int unit, const bf16* QKV, bf16* OB, float* SSQ, LAS unsigned char* lds, LAS unsigned char* vst, int wave, int lane) {
    LAS unsigned char* Ost = lds;
    LAS f32x2* ML = (LAS f32x2*)(lds + 65536);
    const int hb = unit & 7, R = (unit >> 3) & 15, b = unit >> 7, i = lane & 31, hi = lane >> 5;
#pragma unroll 1
    for (int br = 0; br < 3; ++br) {
        const int dil = br == 0 ? 1 : br == 1 ? 4 : 16;
#pragma unroll 1
        for (int k = 0; k < 2; ++k) { const int ti = wave + 8 * k;
            const int r = br == 0 ? 0 : br == 1 ? (ti >> 2) : ti;
            const int m0 = br == 0 ? 512 * R + 32 * ti : br == 1 ? 128 * R + 32 * (ti & 3) : 32 * R;
            float m, l; f32x16 o0, o1;
            attn_wave_tile<false>(QKV, b * SEQ, dil, r, m0, 768 + 64 * hb, 1280 + 64 * hb, 1792 + 64 * hb, 0.f, vst, lane, m, l, o0, o1);
            const int t = (m0 + i) * dil + r, ql = t - 512 * R;
            LAS unsigned char* orow = Ost + ql * 128 + 8 * hi;
            if (br > 0) {
                const f32x2 ms = ML[ql]; const float mn = fmaxf(ms.x, m), a = ex2(ms.x - mn), c = ex2(m - mn);
                l = ms.y * a + l * c; m = mn;
#pragma unroll
                for (int dt = 0; dt < 2; ++dt)
#pragma unroll
                    for (int gq = 0; gq < 4; ++gq) { const u32x2 w = *(const LAS u32x2*)(orow + (32 * dt + 8 * gq) * 2);
                        const float s0 = bf2f(w.x & 0xffffu), s1 = bf2f(w.x >> 16), s2 = bf2f(w.y & 0xffffu), s3 = bf2f(w.y >> 16);
                        if (dt == 0) { o0[4 * gq] = o0[4 * gq] * c + s0 * a; o0[4 * gq + 1] = o0[4 * gq + 1] * c + s1 * a; o0[4 * gq + 2] = o0[4 * gq + 2] * c + s2 * a; o0[4 * gq + 3] = o0[4 * gq + 3] * c + s3 * a; }
                        else { o1[4 * gq] = o1[4 * gq] * c + s0 * a; o1[4 * gq + 1] = o1[4 * gq + 1] * c + s1 * a; o1[4 * gq + 2] = o1[4 * gq + 2] * c + s2 * a; o1[4 * gq + 3] = o1[4 * gq + 3] * c + s3 * a; } }
            }
            if (br < 2) {
                if (hi == 0) ML[ql] = (f32x2){m, l};
#pragma unroll
                for (int dt = 0; dt < 2; ++dt)
#pragma unroll
                    for (int gq = 0; gq < 4; ++gq) { u32x2 w;
                        if (dt == 0) { w.x = pk2(o0[4 * gq], o0[4 * gq + 1]); w.y = pk2(o0[4 * gq + 2], o0[4 * gq + 3]); } else { w.x = pk2(o1[4 * gq], o1[4 * gq + 1]); w.y = pk2(o1[4 * gq + 2], o1[4 * gq + 3]); }
                        *(LAS u32x2*)(orow + (32 * dt + 8 * gq) * 2) = w; }
            } else {
                const int row = b * SEQ + t;
                finalize_store(o0, o1, l, OB + (size_t)row * D + 512 + 64 * hb, SSQ + (size_t)row * 16 + 8 + hb, hi);
            }
        }
        __syncthreads();
    }
}
__device__ __forceinline__ void s_step_w(SSt& st, const f32x4& q4, const f32x4& k4, const f32x4& v4, float w) {
    float s = sum16((q4.x * k4.x + q4.y * k4.y) + (q4.z * k4.z + q4.w * k4.w));
    const bool valid = w > 0.f;
    s = valid ? s : -INFINITY;
    const float mn = fmaxf(st.m, s);
    const float corr = (mn == -INFINITY) ? 1.f : ex2(st.m - mn);
    const float p = valid ? w * ex2(s - mn) : 0.f;
    st.l = st.l * corr + p; st.o = st.o * corr + v4 * p; st.m = mn;
}
__device__ __forceinline__ void s_combine(SSt& a, const SSt& b, bool take) {
    const float mn = fmaxf(a.m, b.m);
    const float ca = (a.m == -INFINITY) ? 0.f : ex2(a.m - mn), cb = (b.m == -INFINITY) ? 0.f : ex2(b.m - mn);
    if (take) { a.l = a.l * ca + b.l * cb; a.o = a.o * ca + b.o * cb; a.m = mn; }
}
__device__ __forceinline__ void sample_B4(int item, const bf16* QKV, const float* cbk, const float* cbv, const float* out, bf16* OB, float* SSQ, int lane) {
    const int c = lane & 15, g = lane >> 4, hb = item & 7, b = item >> 3, row0 = MP + b * DS;
    f32x4 q[4];
#pragma unroll
    for (int i = 0; i < 4; ++i) q[i] = load_q4(QKV, row0 + i, 768 + 64 * hb, c);
    const f32x4 qg = g == 0 ? q[0] : g == 1 ? q[1] : g == 2 ? q[2] : q[3];
    const size_t base = (((size_t)b * WB) * 8 + hb) * 64 + 4 * c;
    SSt sg; sg.m = -INFINITY; sg.l = 0.f; sg.o = (f32x4){0.f, 0.f, 0.f, 0.f};
#pragma unroll 1
    for (int s0 = 0; s0 < 192; s0 += 12) {
        f32x4 k4[12], v4[12];
#pragma unroll
        for (int u = 0; u < 12; ++u) { const int st_ = s0 + u, p = st_ < 96 ? 16 * st_ + g : 1536 + 4 * (st_ - 96) + g;
            k4[u] = __builtin_nontemporal_load((const f32x4*)(cbk + base + (size_t)p * 512)); v4[u] = __builtin_nontemporal_load((const f32x4*)(cbv + base + (size_t)p * 512)); }
#pragma unroll
        for (int u = 0; u < 12; ++u) { const int st_ = s0 + u, p = st_ < 96 ? 16 * st_ + g : 1536 + 4 * (st_ - 96) + g;
            const float w = (st_ >= 96 && (p & 15) == g) ? 2.f : 1.f;
            s_step_w(sg, qg, k4[u], v4[u], w); }
    }
    SSt st[4];
#pragma unroll
    for (int i = 0; i < 4; ++i) { st[i].m = -INFINITY; st[i].l = 0.f; st[i].o = (f32x4){0.f, 0.f, 0.f, 0.f}; }
#pragma unroll 1
    for (int s0 = 0; s0 < 32; s0 += 8) {
        f32x4 k4[8], v4[8];
#pragma unroll
        for (int u = 0; u < 8; ++u) { const int p = 1920 + 4 * (s0 + u) + g;
            k4[u] = __builtin_nontemporal_load((const f32x4*)(cbk + base + (size_t)p * 512)); v4[u] = __builtin_nontemporal_load((const f32x4*)(cbv + base + (size_t)p * 512)); }
#pragma unroll
        for (int u = 0; u < 8; ++u) { const int p = 1920 + 4 * (s0 + u) + g;
#pragma unroll
            for (int i = 0; i < 4; ++i) { const float w = (p >= 1920 + i ? 1.f : 0.f) + ((p & 3) == i ? 1.f : 0.f) + ((p & 15) == i ? 1.f : 0.f);
                s_step_w(st[i], q[i], k4[u], v4[u], w); } }
    }
    {
        const size_t o = (((size_t)b * WB + WB - DS + g) * 8 + hb) * 64 + 4 * c;
        const f32x4 kn = *(const f32x4*)(out + O_SBK + o), vn = *(const f32x4*)(out + O_SBV + o);
#pragma unroll
        for (int i = 0; i < 4; ++i) { const float w = (g <= i ? 1.f : 0.f) + (g == i ? 2.f : 0.f); s_step_w(st[i], q[i], kn, vn, w); }
    }
#pragma unroll
    for (int i = 0; i < 4; ++i) { s_combine(st[i], sg, g == i); s_merge(st[i]);
        s_store(st[i], OB + (size_t)(row0 + i) * D + 512 + 64 * hb, SSQ + (size_t)(row0 + i) * 16 + 8 + hb, lane); }
}

__device__ __forceinline__ void sample_A4(int item, const bf16* QKV, const float* cak, const float* cav, const float* out, const float* sinks, bf16* OB, float* SSQ, int lane) {
    const int c = lane & 15, g = lane >> 4, hpair = item & 1, hkv = (item >> 1) & 1, b = item >> 2, row0 = MP + b * DS, hq0 = 4 * hkv + 2 * hpair;
    f32x4 q[4][2]; SSt st[4][2];
#pragma unroll
    for (int i = 0; i < 4; ++i)
#pragma unroll
        for (int hh = 0; hh < 2; ++hh) { q[i][hh] = load_q4(QKV, row0 + i, 64 * (hq0 + hh), c); st[i][hh].m = -INFINITY; st[i][hh].l = 0.f; st[i][hh].o = (f32x4){0.f, 0.f, 0.f, 0.f}; }
    const size_t base = (((size_t)b * WA) * 2 + hkv) * 64 + 4 * c;
#pragma unroll 1
    for (int s0 = 0; s0 < 32; s0 += 8) {
        f32x4 k4[8], v4[8];
#pragma unroll
        for (int u = 0; u < 8; ++u) { const int j = 4 * (s0 + u) + g;
            k4[u] = __builtin_nontemporal_load((const f32x4*)(cak + base + (size_t)j * 128)); v4[u] = __builtin_nontemporal_load((const f32x4*)(cav + base + (size_t)j * 128)); }
#pragma unroll
        for (int u = 0; u < 8; ++u) { const int j = 4 * (s0 + u) + g;
#pragma unroll
            for (int i = 0; i < 4; ++i) { const float w = j >= i + 1 ? 1.f : 0.f;
#pragma unroll
                for (int hh = 0; hh < 2; ++hh) s_step_w(st[i][hh], q[i][hh], k4[u], v4[u], w); } }
    }
    {
        const size_t o = (((size_t)b * WA + WA - DS + g) * 2 + hkv) * 64 + 4 * c;
        const f32x4 kn = *(const f32x4*)(out + O_SAK + o), vn = *(const f32x4*)(out + O_SAV + o);
#pragma unroll
        for (int i = 0; i < 4; ++i) { const float w = g <= i ? 1.f : 0.f;
#pragma unroll
            for (int hh = 0; hh < 2; ++hh) s_step_w(st[i][hh], q[i][hh], kn, vn, w); }
    }
#pragma unroll
    for (int i = 0; i < 4; ++i)
#pragma unroll
        for (int hh = 0; hh < 2; ++hh) { SSt& t = st[i][hh]; s_merge(t);
            const float sk = sinks[hq0 + hh] * LOG2E, mn = fmaxf(t.m, sk), a = ex2(t.m - mn); t.l = t.l * a + ex2(sk - mn); t.o = t.o * a; t.m = mn;
            s_store(t, OB + (size_t)(row0 + i) * D + 64 * (hq0 + hh), SSQ + (size_t)(row0 + i) * 16 + hq0 + hh, lane); }
}

struct Args { const float* in[21]; float* out; unsigned char* ws; };
__global__ void __launch_bounds__(NTHREADS, 2) mk_fwd(Args args) {
    extern __shared__ __attribute__((aligned(16))) unsigned char lds_raw[];
    LAS unsigned char* lds = (LAS unsigned char*)lds_raw;
    volatile LAS unsigned* MISC = (volatile LAS unsigned*)(lds + MISC_OFF);
    const int tid = threadIdx.x, lane = tid & 63, wave = __builtin_amdgcn_readfirstlane(tid >> 6);
    const int bx = blockIdx.x;
    constexpr int G = NCOMP;
    const int gw = bx * NWAVES + wave; constexpr int NGW = G * NWAVES;
    unsigned char* ws = args.ws;
    gu32* ctl = (gu32*)(ws + WS_CTL);
    const float* xp = args.in[0]; const float* xs = args.in[1]; const float* cp = args.in[2]; const float* cs = args.in[3];
    const float* cak = args.in[4]; const float* cav = args.in[5]; const float* cbk = args.in[6]; const float* cbv = args.in[7];
    const float* w_ada = args.in[8]; const float* b_ada = args.in[9]; const float* g_attn = args.in[10]; const float* w_in = args.in[11];
    const float* sinks = args.in[12]; const float* g_oa = args.in[13]; const float* g_ob = args.in[14]; const float* w_o = args.in[15];
    const float* g_ffn = args.in[16]; const float* w_gate = args.in[17]; const float* w_up = args.in[18]; const float* w_down = args.in[19];
    const float* g_final = args.in[20];
    float* out = args.out;
    float* MOD = (float*)(ws + WS_MOD); float* COS = (float*)(ws + WS_COS); float* SIN = (float*)(ws + WS_SIN); float* SSQ = (float*)(ws + WS_SSQ);
    bf16* Win_t = (bf16*)(ws + WS_WIN); bf16* Wo_t = (bf16*)(ws + WS_WO); bf16* Wgu_t = (bf16*)(ws + WS_WGU); bf16* Wd_t = (bf16*)(ws + WS_WD);
    bf16* XN = (bf16*)(ws + WS_XN); bf16* QKV = (bf16*)(ws + WS_QKV); bf16* OB = (bf16*)(ws + WS_OB); bf16* X1 = (bf16*)(ws + WS_X1); bf16* HM = (bf16*)(ws + WS_HM); bf16* X2 = (bf16*)(ws + WS_X2);

    for (int u = tid; u < (LDS_BYTES - LDSCTL_OFF) / 4; u += NTHREADS) ((LAS unsigned*)(lds + LDSCTL_OFF))[u] = 0u;
    __syncthreads();
    if (bx >= NCOMP) {
        const int cb = bx - NCOMP;
        {
            constexpr int PA = (WA - DS) * 128 / 4;
            for (int e = cb * NTHREADS + tid; e < 2 * DB * PA; e += NCOPY * NTHREADS) { const int arr = e / (DB * PA), rem = e - arr * (DB * PA), b = rem / PA, i4 = rem - b * PA;
                const size_t bo = (size_t)b * WA * 128;
                ((f32x4*)(out + (arr ? O_SAV : O_SAK) + bo))[i4] = ((const f32x4*)((arr ? cav : cak) + bo + DS * 128))[i4]; }
        }
        copy_drain(ctl + CW_COPY_HEAD, ctl + CW_PAUSE, lane, cbk, cbv, out);
        return;
    }
    XcdBarrier bar = xcd_barrier_post((unsigned*)(ctl + CW_BAR), MISC + 8);

    if (bx < NMOD / 32) ada_block(lds, bx, cp, cs, w_ada, b_ada, MOD, tid, wave, lane);
    {
        LAS float* scr = (LAS float*)(lds + RING_OFF + wave * 16384);
        constexpr int I_IN = (D / 64) * (INC / 32), I_O = (D / 64) * (D / 32), I_G = (D / 64) * (FF / 32), I_D = (FF / 64) * (D / 32);
        const int rw = NGW - 1 - gw;
        transpose_matrix(w_in, D, INC, Win_t, RmIn(), nullptr, nullptr, scr, rw, NGW, I_IN, lane);
        transpose_matrix(w_gate, D, FF, Wgu_t, RmGate(), nullptr, nullptr, scr, rw, NGW, I_G, lane);
        transpose_matrix(w_up, D, FF, Wgu_t, RmUp(), nullptr, nullptr, scr, rw, NGW, I_G, lane);
        transpose_matrix(w_down, FF, D, Wd_t, RmId(), nullptr, nullptr, scr, rw, NGW, I_D, lane);
        transpose_matrix(w_o, D, D, Wo_t, RmId(), g_oa, g_ob, scr, rw, NGW, I_O, lane);
        for (int e = bx * NTHREADS + tid; e < NPOS * 32; e += G * NTHREADS) rope_entry(e, COS, SIN);
    }
    xcd_barrier(bar);
    for (int row = gw; row < MT; row += NGW) {
        const float* xrow = row < MP ? xp + (size_t)row * D : xs + (size_t)(row - MP) * D; const float* mr = MOD + (size_t)mod_row(row) * NMOD;
        normmod_row(xrow, g_attn, mr, mr + 1024, XN + (size_t)row * D, lane);
    }
    xcd_barrier(bar);
    {
        pg8::Gemm g{XN, Win_t, MT, INC, D}; pg8::StaticOrder S; S.init(MT, INC, G, bx);
        pg8::EpiQKV E{QKV, COS, SIN, out};
        pg8::gemm_phase<pg8::EpiQKV, pg8::StaticOrder, true, true>(lds + RING_OFF, g, S, E);
    }
    xcd_barrier(bar);
    {
        LAS unsigned char* vst = lds + 73728 + wave * 4096;
        const unsigned xme = xb_xcc_id() & 7u;
        for (unsigned tq = 0; tq < 8u; ++tq) { const int x = (int)((xme + tq) & 7u);
            for (;;) {
                const int e = q_pop(ctl + CW_ATTQ + 64 * x, MISC + 17, tid);
                if (e >= 96) break;
                const int k = e / 6, r = e - 6 * k;
                int ln = lane; asm volatile("" : "+v"(ln));
                const int pr = 2 * x + ((r - 1) & 1), unit = ((pr >> 3) << 7) | (k << 3) | (pr & 7);
                if (r == 0) sample_B4((16 * x + k) * 8 + wave, QKV, cbk, cbv, out, OB, SSQ, ln);
                else if (r < 3) unit_B(unit, QKV, OB, SSQ, lds, vst, wave, ln);
                else if (r < 5) unit_A(unit, QKV, sinks, OB, SSQ, vst, wave, ln);
                else if ((k & 1) == 0) sample_A4((8 * x + (k >> 1)) * 8 + wave, QKV, cak, cav, out, sinks, OB, SSQ, ln);
            }
        }
    }
    xcd_barrier(bar);
    {
        pg8::Gemm g{OB, Wo_t, MT, D, D}; pg8::StaticOrder S; S.init(MT, D, G, bx);
        LAS pg8::f32x2v* tab = (LAS pg8::f32x2v*)(lds + TAB_OFF);
        for (int ui = 0; ui < 2; ++ui) { pg8::Unit u;
            if (S.next(ui, u) && tid < 256) { const int row = u.pm * 256 + tid; const f32x4* sp = (const f32x4*)(SSQ + (size_t)row * 16);
                const f32x4 a0 = sp[0], a1 = sp[1], b0 = sp[2], b1 = sp[3];
                const float sa = ((a0.x + a0.y) + (a0.z + a0.w)) + ((a1.x + a1.y) + (a1.z + a1.w)), sb = ((b0.x + b0.y) + (b0.z + b0.w)) + ((b1.x + b1.y) + (b1.z + b1.w));
                const float ra = 1.f / sqrtf(sa * (1.f / 512.f) + EPS), rb = 1.f / sqrtf(sb * (1.f / 512.f) + EPS);
                tab[ui * 256 + tid] = (pg8::f32x2v){ra / rb, rb}; } }
        __syncthreads();
        pg8::EpiOut E{MOD, X1, tab, (unsigned*)(ctl + CW_PANEL4)};
        pg8::gemm_phase<pg8::EpiOut, pg8::StaticOrder, true, true>(lds + RING_OFF, g, S, E);
        for (;;) {
            const int item = q_pop(ctl + CW_P5_HEAD, MISC + 18, tid);
            if (item >= (MT / 256) * 8) break;
            const int pm = item >> 3;
            if (tid == 0) { unsigned sp = 0; while (__hip_atomic_load(ctl + CW_PANEL4 + 64 * pm, RLX_AGENT) < 32u && ++sp < (1u << 22)) __builtin_amdgcn_s_sleep(4);
                __builtin_amdgcn_fence(__ATOMIC_ACQUIRE, "agent"); asm volatile("s_waitcnt vmcnt(0)" ::: "memory"); }
            __syncthreads();
#pragma unroll 1
            for (int j = 0; j < 4; ++j) { const int row = item * 32 + wave * 4 + j; const float* mr = MOD + (size_t)mod_row(row) * NMOD;
                const float* xrow = row < MP ? xp + (size_t)row * D : xs + (size_t)(row - MP) * D;
                resid_normmod_row(xrow, X1 + (size_t)row * D, g_ffn, mr + 3072, mr + 4096, XN + (size_t)row * D, lane); }
        }
    }
    xcd_barrier(bar);
    {
        pg8::Gemm g{XN, Wgu_t, MT, 2 * FF, D}; pg8::StaticOrder S; S.init(MT, 2 * FF, G, bx);
        pg8::EpiGU E{HM};
        pg8::gemm_phase<pg8::EpiGU, pg8::StaticOrder, true, true>(lds + RING_OFF, g, S, E);
    }
    xcd_barrier(bar);
    {
        pg8::Gemm g{HM, Wd_t, MT, D, FF}; pg8::StaticOrder S; S.init(MT, D, G, bx);
        pg8::EpiDown E{X1, MOD, X2, (unsigned*)(ctl + CW_PANEL7)};
        pg8::gemm_phase<pg8::EpiDown, pg8::StaticOrder, true, true>(lds + RING_OFF, g, S, E);
        for (;;) {
            const int item = q_pop(ctl + CW_P8_HEAD, MISC + 19, tid);
            if (item >= (MT / 256) * 8) break;
            const int pm = item >> 3;
            if (tid == 0) { unsigned sp = 0; while (__hip_atomic_load(ctl + CW_PANEL7 + 64 * pm, RLX_AGENT) < 32u && ++sp < (1u << 22)) __builtin_amdgcn_s_sleep(4);
                __builtin_amdgcn_fence(__ATOMIC_ACQUIRE, "agent"); asm volatile("s_waitcnt vmcnt(0)" ::: "memory"); }
            __syncthreads();
#pragma unroll 1
            for (int j = 0; j < 4; ++j) { const int row = item * 32 + wave * 4 + j; final_row(X2 + (size_t)row * D, out + O_Y + (size_t)row * D, g_final, lane); }
        }
    }
    copy_drain(ctl + CW_COPY_HEAD, nullptr, lane, cbk, cbv, out);
}

extern "C" void kernel_launch(void* const* d_in, const int* in_sizes, int n_in, void* d_out, int out_size, void* d_ws, size_t ws_size, hipStream_t stream) {
    static int grid = 0;
    if (grid == 0) {
        if (n_in != 21 || (size_t)out_size != O_END || ws_size < WS_END) { fprintf(stderr, "kernel_launch: unexpected shapes (n_in %d, out %d, ws %zu); nothing launched\n", n_in, out_size, ws_size); grid = -1; return; }
        if (hipFuncSetAttribute((const void*)mk_fwd, hipFuncAttributeMaxDynamicSharedMemorySize, LDS_BYTES) != hipSuccess) { fprintf(stderr, "kernel_launch: hipFuncSetAttribute failed\n"); grid = -1; return; }
        int per_cu = 0;
        if (hipOccupancyMaxActiveBlocksPerMultiprocessor(&per_cu, (const void*)mk_fwd, NTHREADS, LDS_BYTES) != hipSuccess || per_cu < 1) fprintf(stderr, "kernel_launch: note: occupancy query reports %d workgroups per CU\n", per_cu);
        (void)hipGetLastError();
        grid = NGRID;
    }
    if (grid < 0) return;
    (void)in_sizes;
    if (hipMemsetAsync((char*)d_ws + WS_CTL, 0, CTL_ZERO_BYTES, stream) != hipSuccess) { fprintf(stderr, "kernel_launch: hipMemsetAsync failed\n"); return; }
    Args a{};
    for (int i = 0; i < 21; ++i) a.in[i] = (const float*)d_in[i];
    a.out = (float*)d_out; a.ws = (unsigned char*)d_ws;
    hipLaunchKernelGGL(mk_fwd, dim3(grid), dim3(NTHREADS), LDS_BYTES, stream, a);
    const hipError_t le = hipPeekAtLastError();
    if (le != hipSuccess) fprintf(stderr, "kernel_launch: launch failed: %s\n", hipGetErrorName(le));
}
```
